# Optimizing an MI355X kernel written in HIP

```python
import math
import jax, jax.numpy as jnp
from jax import lax
import numpy as np

D_MODEL = 2048
BATCH = 1
SEQ = 8192
DEPTH = 4

DIFF_HEADS = 8
DIFF_QK_DIM = 64
DIFF_V_DIM = 128
DIFF_WIDTH = DIFF_HEADS * DIFF_V_DIM
MLA_HEADS = 8
MLA_Q_RANK = 512
MLA_KV_RANK = 512
MLA_NOPE_DIM = 128
MLA_ROPE_DIM = 64
MLA_V_DIM = 128
MLA_WIDTH = MLA_HEADS * MLA_V_DIM
MIX_WIDTH = DIFF_WIDTH + MLA_WIDTH
IN_SIZES = (
    DIFF_HEADS * 2 * DIFF_QK_DIM,
    DIFF_HEADS * 2 * DIFF_QK_DIM,
    DIFF_WIDTH,
    DIFF_WIDTH,
    MLA_Q_RANK,
    MLA_KV_RANK,
    MLA_ROPE_DIM,
    MLA_WIDTH,
)
IN_WIDTH = sum(IN_SIZES)
ROPE_THETA = 10000.0
NUM_BUCKETS = 32
MAX_DISTANCE = 128
BLOCK_Q = 128
EPS = 1e-6
NEG_INF = -1e30

kernel_name = "hymba_diffattn_mla_hybrid"


def _rms_norm(x, g):
    xf = x.astype(jnp.float32)
    y = xf * lax.rsqrt(jnp.mean(xf * xf, axis=-1, keepdims=True) + EPS)
    return (y * g.astype(jnp.float32)).astype(x.dtype)


def _rope_tables(seq):
    pos = jnp.arange(seq, dtype=jnp.float32)
    inv = 1.0 / (ROPE_THETA ** (jnp.arange(0, MLA_ROPE_DIM, 2, dtype=jnp.float32) / MLA_ROPE_DIM))
    ang = pos[:, None] * inv[None, :]
    ang = jnp.concatenate([ang, ang], axis=-1)
    return jnp.cos(ang), jnp.sin(ang)


def _apply_rope(x, cos, sin):
    half = x.shape[-1] // 2
    x1, x2 = x[..., :half], x[..., half:]
    rot = jnp.concatenate([-x2, x1], axis=-1)
    return x * cos.astype(x.dtype) + rot * sin.astype(x.dtype)


def _t5_bucket(dist):
    n = jnp.maximum(dist, 0)
    max_exact = NUM_BUCKETS // 2
    nf = jnp.maximum(n, 1).astype(jnp.float32)
    large = max_exact + (jnp.log(nf / max_exact) / math.log(MAX_DISTANCE / max_exact)
                         * (NUM_BUCKETS - max_exact)).astype(jnp.int32)
    large = jnp.minimum(large, NUM_BUCKETS - 1)
    return jnp.where(n < max_exact, n, large)


def _block_sweep(one_block, seq):
    starts = jnp.arange(seq // BLOCK_Q, dtype=jnp.int32) * BLOCK_Q
    out = lax.map(one_block, starts)
    out = jnp.moveaxis(out, 0, 1)
    b, nb, q, h, dv = out.shape
    return out.reshape(b, nb * q, h, dv)


def _diff_attention(q, k, v, lam, bias_table):
    seq = q.shape[1]
    kpos = jnp.arange(seq, dtype=jnp.int32)
    scale = DIFF_QK_DIM ** -0.5
    table = bias_table.astype(jnp.float32)

    def one_block(start):
        qb = lax.dynamic_slice_in_dim(q, start, BLOCK_Q, axis=1)
        s = jnp.einsum('bqhmd,bkhmd->bmhqk', qb, k).astype(jnp.float32) * scale
        dist = (start + jnp.arange(BLOCK_Q, dtype=jnp.int32))[:, None] - kpos[None, :]
        bias = jnp.transpose(table[_t5_bucket(dist)], (2, 0, 1))
        s = jnp.where((dist >= 0)[None, None, None], s + bias[None, None], NEG_INF)
        p = jax.nn.softmax(s, axis=-1)
        w = p[:, 0] - lam * p[:, 1]
        return jnp.einsum('bhqk,bkhd->bqhd', w.astype(v.dtype), v)

    return _block_sweep(one_block, seq)


def _mla_attention(q_nope, q_rope, k_nope, k_rope, v):
    seq = q_nope.shape[1]
    kpos = jnp.arange(seq, dtype=jnp.int32)
    scale = (MLA_NOPE_DIM + MLA_ROPE_DIM) ** -0.5

    def one_block(start):
        qn = lax.dynamic_slice_in_dim(q_nope, start, BLOCK_Q, axis=1)
        qr = lax.dynamic_slice_in_dim(q_rope, start, BLOCK_Q, axis=1)
        s = (jnp.einsum('bqhd,bkhd->bhqk', qn, k_nope)
             + jnp.einsum('bqhr,bkr->bhqk', qr, k_rope)).astype(jnp.float32) * scale
        dist = (start + jnp.arange(BLOCK_Q, dtype=jnp.int32))[:, None] - kpos[None, :]
        s = jnp.where((dist >= 0)[None, None], s, NEG_INF)
        p = jax.nn.softmax(s, axis=-1)
        return jnp.einsum('bhqk,bkhd->bqhd', p.astype(v.dtype), v)

    return _block_sweep(one_block, seq)


def setup_inputs(seed: int = 0) -> dict:
    key = jax.random.key(seed)
    ks = jax.random.split(key, 12)
    f32 = jnp.float32
    x = jax.random.normal(ks[0], (BATCH, SEQ, D_MODEL), f32)
    norm_g = 1.0 + 0.02 * jax.random.normal(ks[1], (DEPTH, D_MODEL), f32)
    w_in = jax.random.normal(ks[2], (DEPTH, D_MODEL, IN_WIDTH), f32) * D_MODEL ** -0.5
    diff_lambda = 0.1 * jax.random.normal(ks[3], (DEPTH, 4, DIFF_QK_DIM), f32)
    diff_subln_g = 1.0 + 0.02 * jax.random.normal(ks[4], (DEPTH, DIFF_V_DIM), f32)
    rel_bias_table = 0.2 * jax.random.normal(ks[5], (NUM_BUCKETS, DIFF_HEADS), f32)
    mla_q_norm_g = 1.0 + 0.02 * jax.random.normal(ks[6], (DEPTH, MLA_Q_RANK), f32)
    w_uq = jax.random.normal(ks[7], (DEPTH, MLA_Q_RANK, MLA_HEADS * (MLA_NOPE_DIM + MLA_ROPE_DIM)), f32) * MLA_Q_RANK ** -0.5
    mla_kv_norm_g = 1.0 + 0.02 * jax.random.normal(ks[8], (DEPTH, MLA_KV_RANK), f32)
    w_ukv = jax.random.normal(ks[9], (DEPTH, MLA_KV_RANK, MLA_HEADS * (MLA_NOPE_DIM + MLA_V_DIM)), f32) * MLA_KV_RANK ** -0.5
    w_out = jax.random.normal(ks[10], (DEPTH, MIX_WIDTH, D_MODEL), f32) * MIX_WIDTH ** -0.5
    final_norm_g = 1.0 + 0.02 * jax.random.normal(ks[11], (D_MODEL,), f32)
    return {"x": x, "norm_g": norm_g, "w_in": w_in, "diff_lambda": diff_lambda,
            "diff_subln_g": diff_subln_g, "rel_bias_table": rel_bias_table,
            "mla_q_norm_g": mla_q_norm_g, "w_uq": w_uq, "mla_kv_norm_g": mla_kv_norm_g,
            "w_ukv": w_ukv, "w_out": w_out, "final_norm_g": final_norm_g}


def reference(x, norm_g, w_in, diff_lambda, diff_subln_g, rel_bias_table,
              mla_q_norm_g, w_uq, mla_kv_norm_g, w_ukv, w_out, final_norm_g):
    b, seq, _ = x.shape
    cos, sin = _rope_tables(seq)
    split_points = [int(v) for v in np.cumsum(IN_SIZES)[:-1]]
    for l in range(DEPTH):
        h = _rms_norm(x, norm_g[l])
        proj = jnp.einsum('bsd,de->bse', h, w_in[l])
        q_a, k_a, v_a, z_a, c_q, c_kv, k_r, z_b = jnp.split(proj, split_points, axis=-1)

        lambda_init = 0.8 - 0.6 * math.exp(-0.3 * l)
        lp = diff_lambda[l].astype(jnp.float32)
        lam = (jnp.exp(jnp.sum(lp[0] * lp[1])) - jnp.exp(jnp.sum(lp[2] * lp[3])) + lambda_init)
        qa = q_a.reshape(b, seq, DIFF_HEADS, 2, DIFF_QK_DIM)
        ka = k_a.reshape(b, seq, DIFF_HEADS, 2, DIFF_QK_DIM)
        va = v_a.reshape(b, seq, DIFF_HEADS, DIFF_V_DIM)
        o_a = _diff_attention(qa, ka, va, lam, rel_bias_table)
        o_a = _rms_norm(o_a, diff_subln_g[l]) * (1.0 - lambda_init)
        o_a = o_a.reshape(b, seq, DIFF_WIDTH) * jax.nn.silu(z_a)

        q_b = jnp.einsum('bsr,re->bse', _rms_norm(c_q, mla_q_norm_g[l]), w_uq[l])
        q_b = q_b.reshape(b, seq, MLA_HEADS, MLA_NOPE_DIM + MLA_ROPE_DIM)
        q_nope, q_rope = q_b[..., :MLA_NOPE_DIM], q_b[..., MLA_NOPE_DIM:]
        q_rope = _apply_rope(q_rope, cos[:, None, :], sin[:, None, :])
        kv = jnp.einsum('bsr,re->bse', _rms_norm(c_kv, mla_kv_norm_g[l]), w_ukv[l])
        kv = kv.reshape(b, seq, MLA_HEADS, MLA_NOPE_DIM + MLA_V_DIM)
        k_nope, v_b = kv[..., :MLA_NOPE_DIM], kv[..., MLA_NOPE_DIM:]
        k_rope = _apply_rope(k_r, cos, sin)
        o_b = _mla_attention(q_nope, q_rope, k_nope, k_rope, v_b)
        o_b = o_b.reshape(b, seq, MLA_WIDTH) * jax.nn.silu(z_b)

        mixed = jnp.concatenate([o_a, o_b], axis=-1)
        x = x + jnp.einsum('bse,ed->bsd', mixed, w_out[l])
    return _rms_norm(x, final_norm_g)
```

```cpp
#include <hip/hip_runtime.h>
#include <hip/hip_cooperative_groups.h>
#include <cstdio>
#include <cstdint>
namespace cg = cooperative_groups;

#ifndef ONE_LAUNCH
#define ONE_LAUNCH 1
#endif

#define DI __device__ __forceinline__
typedef unsigned short u16;
typedef short bf16x8 __attribute__((ext_vector_type(8)));
typedef short s16x4 __attribute__((ext_vector_type(4)));
typedef float f32x16 __attribute__((ext_vector_type(16)));
typedef float f32x4 __attribute__((ext_vector_type(4)));
typedef float f32x2 __attribute__((ext_vector_type(2)));
typedef unsigned u32x2 __attribute__((ext_vector_type(2)));
typedef unsigned u32x4 __attribute__((ext_vector_type(4)));
typedef __bf16 bf2_t __attribute__((ext_vector_type(2)));

constexpr int S = 8192, DM = 2048, DEPTH = 4;
constexpr int INW = 6208, INWP = 6400;
constexpr int NTHREADS = 512;
constexpr float EPS = 1e-6f;
constexpr float LOG2E = 1.4426950408889634f;
constexpr float QSCALE_A = 0.125f * 1.4426950408889634f;
constexpr float QSCALE_B = 0.07216878364870322f * 1.4426950408889634f;
constexpr float RESCALE_THR = 6.0f;

constexpr int GS = 144;
constexpr int G_TILE = 256 * GS;
constexpr int RS_OFF = 4 * G_TILE;
constexpr int LDS_BYTES = RS_OFF + 1024;
constexpr int AT_KBUF = 25600;
constexpr int AT_VOFF = 2 * AT_KBUF;
constexpr int VS = 144;
constexpr int AT_VBUF = 128 * VS;
constexpr int LUT_OFF = AT_VOFF + 2 * AT_VBUF;
constexpr int UBOX_OFF = LUT_OFF + 544;

struct Params {
  const float *x, *norm_g, *w_in, *diff_lambda, *subln_g, *bias_tab, *qnorm_g, *w_uq, *kvnorm_g, *w_ukv, *w_out, *final_g;
  float* out;
  u16 *WinT, *WuqT, *WukvT, *WoutT;
  float* X; u16* XB;
  u16 *QA, *KA, *VAT, *ZG, *CQ, *CKV, *KB, *QB, *VBT, *MIX;
  float *STASH, *RCOS, *RSIN, *BLUT, *LAM, *XSS;
  unsigned* counters;
};

DI unsigned pk_bf16(float lo, float hi) {
  f32x2 v = {lo, hi};
  bf2_t r = __builtin_convertvector(v, bf2_t);
  return __builtin_bit_cast(unsigned, r);
}
DI float bf_lo(unsigned u) { return __uint_as_float(u << 16); }
DI float bf_hi(unsigned u) { return __uint_as_float(u & 0xffff0000u); }
DI float silu_f(float z) { return z * __builtin_amdgcn_rcpf(1.0f + __builtin_amdgcn_exp2f(-z * LOG2E)); }
DI float lambda_init(int l) { return l == 0 ? 0.2f : (l == 1 ? 0.35550906759096926f : (l == 2 ? 0.47071301834358414f : 0.5560582041575661f)); }
#define MFMA32(a, b, c) __builtin_amdgcn_mfma_f32_32x32x16_bf16((a), (b), (c), 0, 0, 0)
DI float xhalf_max(float x) {
  u32x2 r = __builtin_amdgcn_permlane32_swap(__float_as_uint(x), __float_as_uint(x), false, false);
  return fmaxf(__uint_as_float(r[0]), __uint_as_float(r[1]));
}
DI float xhalf_sum(float x) {
  u32x2 r = __builtin_amdgcn_permlane32_swap(__float_as_uint(x), __float_as_uint(x), false, false);
  return __uint_as_float(r[0]) + __uint_as_float(r[1]);
}
DI int tid() { int t = threadIdx.x; asm volatile("" : "+v"(t)); return t; }

template <bool SWAP, bool SSQ, bool ZERO = true>
DI void gemm_main(const u16* __restrict__ A, int lda, const u16* __restrict__ Bt, int ldb, int K, char* lds,
                  f32x16 (&acc)[4][2], float* rs_lds) {
  const int t = tid(), lane = t & 63, w = t >> 6, wm = w >> 2, wn = w & 3;
  const int r = lane & 31, hf = lane >> 5;
  const int lr = t >> 3, lc = t & 7;
  const u16* ap = A + (size_t)lr * lda + lc * 8;
  const u16* bp = Bt + (size_t)lr * ldb + lc * 8;
  u32x4 ra[4], rb[4];
  float ssq[4] = {0.f, 0.f, 0.f, 0.f};
  if (ZERO) {
#pragma unroll
    for (int mt = 0; mt < 4; ++mt)
#pragma unroll
      for (int nt = 0; nt < 2; ++nt)
#pragma unroll
        for (int i = 0; i < 16; ++i) acc[mt][nt][i] = 0.f;
  }
  const int nk = K >> 6;
  char* const wbase = lds + lr * GS + lc * 16;
  const char* abase = lds + (wm * 128 + r) * GS + hf * 16;
  const char* bbase = lds + G_TILE + (wn * 64 + r) * GS + hf * 16;
#define G_LOAD(KT) do { const int k0_ = (KT) << 6; _Pragma("unroll") for (int p = 0; p < 4; ++p) { \
    ra[p] = *(const u32x4*)(ap + (size_t)(64 * p) * lda + k0_); rb[p] = *(const u32x4*)(bp + (size_t)(64 * p) * ldb + k0_); } } while (0)
#define G_WRITE(STG) do { char* a_ = wbase + (STG) * 2 * G_TILE; _Pragma("unroll") for (int p = 0; p < 4; ++p) { \
    *(u32x4*)(a_ + 64 * p * GS) = ra[p]; *(u32x4*)(a_ + G_TILE + 64 * p * GS) = rb[p]; \
    if (SSQ) { _Pragma("unroll") for (int e = 0; e < 4; ++e) { const float lo_ = bf_lo(ra[p][e]), hi_ = bf_hi(ra[p][e]); \
      ssq[p] = fmaf(lo_, lo_, ssq[p]); ssq[p] = fmaf(hi_, hi_, ssq[p]); } } } } while (0)
#define G_LOAD_B(KT) do { const int k0_ = (KT) << 6; _Pragma("unroll") for (int p = 0; p < 4; ++p) rb[p] = *(const u32x4*)(bp + (size_t)(64 * p) * ldb + k0_); } while (0)
#define G_LOAD_A(KT) do { const int k0_ = (KT) << 6; _Pragma("unroll") for (int p = 0; p < 4; ++p) ra[p] = *(const u32x4*)(ap + (size_t)(64 * p) * lda + k0_); } while (0)
#define G_WRITE_B(STG) do { char* a_ = wbase + (STG) * 2 * G_TILE + G_TILE; _Pragma("unroll") for (int p = 0; p < 4; ++p) *(u32x4*)(a_ + 64 * p * GS) = rb[p]; } while (0)
#define G_WRITE_A(STG) do { char* a_ = wbase + (STG) * 2 * G_TILE; _Pragma("unroll") for (int p = 0; p < 4; ++p) { \
    *(u32x4*)(a_ + 64 * p * GS) = ra[p]; \
    if (SSQ) { _Pragma("unroll") for (int e = 0; e < 4; ++e) { const float lo_ = bf_lo(ra[p][e]), hi_ = bf_hi(ra[p][e]); \
      ssq[p] = fmaf(lo_, lo_, ssq[p]); ssq[p] = fmaf(hi_, hi_, ssq[p]); } } } } while (0)
  G_LOAD(0);
  __syncthreads();
  G_WRITE(0);
  G_LOAD(1);
  __syncthreads();
#pragma nounroll
  for (int kt = 0; kt < nk; ++kt) {
    const int st = (kt & 1) * 2 * G_TILE;
    {
      bf16x8 fa[2][4], fb[2][2];
#pragma unroll
      for (int i = 0; i < 4; ++i) fa[0][i] = *(const bf16x8*)(abase + st + i * 32 * GS);
#pragma unroll
      for (int i = 0; i < 2; ++i) fb[0][i] = *(const bf16x8*)(bbase + st + i * 32 * GS);
#pragma unroll
      for (int ks = 0; ks < 4; ++ks) {
        if (ks + 1 < 4) {
#pragma unroll
          for (int i = 0; i < 4; ++i) fa[(ks + 1) & 1][i] = *(const bf16x8*)(abase + st + i * 32 * GS + (ks + 1) * 32);
#pragma unroll
          for (int i = 0; i < 2; ++i) fb[(ks + 1) & 1][i] = *(const bf16x8*)(bbase + st + i * 32 * GS + (ks + 1) * 32);
        }
        __builtin_amdgcn_sched_barrier(0);
        __builtin_amdgcn_s_setprio(1);
#pragma unroll
        for (int mt = 0; mt < 4; ++mt)
#pragma unroll
          for (int nt = 0; nt < 2; ++nt)
            acc[mt][nt] = SWAP ? MFMA32(fb[ks & 1][nt], fa[ks & 1][mt], acc[mt][nt]) : MFMA32(fa[ks & 1][mt], fb[ks & 1][nt], acc[mt][nt]);
        __builtin_amdgcn_s_setprio(0);
        __builtin_amdgcn_sched_barrier(0);
        if (ks == 1) {
          if (kt + 1 < nk) G_WRITE_B((kt + 1) & 1);
          if (kt + 2 < nk) G_LOAD_B(kt + 2);
        }
      }
    }
    if (kt + 1 < nk) G_WRITE_A((kt + 1) & 1);
    if (kt + 2 < nk) G_LOAD_A(kt + 2);
    __syncthreads();
  }
#undef G_LOAD
#undef G_WRITE
#undef G_LOAD_A
#undef G_LOAD_B
#undef G_WRITE_A
#undef G_WRITE_B
  if (SSQ) {
    const float invk = 1.0f / (float)K;
#pragma unroll
    for (int p = 0; p < 4; ++p) {
      float v = ssq[p];
      v += __shfl_xor(v, 1); v += __shfl_xor(v, 2); v += __shfl_xor(v, 4);
      if (lc == 0) rs_lds[lr + 64 * p] = rsqrtf(v * invk + EPS);
    }
    __syncthreads();
  }
}

DI void st8_pair_bf16(u16* dst, const float (&x)[4], const float (&y)[4]) {
  unsigned x0 = pk_bf16(x[0], x[1]), x1 = pk_bf16(x[2], x[3]), y0 = pk_bf16(y[0], y[1]), y1 = pk_bf16(y[2], y[3]);
  const u32x2 r0 = __builtin_amdgcn_permlane32_swap(x0, y0, false, false);
  const u32x2 r1 = __builtin_amdgcn_permlane32_swap(x1, y1, false, false);
  u32x4 v = {r0[0], r1[0], r0[1], r1[1]};
  *(u32x4*)dst = v;
}
DI void st4_bf16(u16* dst, float a, float b, float c, float d) { u32x2 v = {pk_bf16(a, b), pk_bf16(c, d)}; *(u32x2*)dst = v; }

DI void epi_vt(const f32x16 (&acc)[4][2], u16* VT, int vrow0, int m0, const float* rs_lds) {
  const int t = tid(), lane = t & 63, w = t >> 6, wm = w >> 2, wn = w & 3, r = lane & 31, hf = lane >> 5;
#pragma unroll
  for (int mt = 0; mt < 4; ++mt)
#pragma unroll
    for (int a = 0; a < 2; ++a) {
      const int mlx = wm * 128 + mt * 32 + 16 * a + 4 * hf;
      const f32x4 rsx = *(const f32x4*)(rs_lds + mlx), rsy = *(const f32x4*)(rs_lds + mlx + 8);
#pragma unroll
      for (int nt = 0; nt < 2; ++nt) {
        float x[4], y[4];
#pragma unroll
        for (int e = 0; e < 4; ++e) { x[e] = acc[mt][nt][8 * a + e] * rsx[e]; y[e] = acc[mt][nt][8 * a + 4 + e] * rsy[e]; }
        st8_pair_bf16(VT + (size_t)(vrow0 + wn * 64 + nt * 32 + r) * S + m0 + wm * 128 + mt * 32 + 16 * a + 8 * hf, x, y);
      }
    }
}

template <bool SILU>
DI void epi_row(const f32x16 (&acc)[4][2], u16* dst, int ld, int c0, int m0, const float* rs_lds, float mul) {
  const int t = tid(), lane = t & 63, w = t >> 6, wm = w >> 2, r = lane & 31, hf = lane >> 5;
#pragma unroll
  for (int mt = 0; mt < 4; ++mt) {
    const int ml = wm * 128 + mt * 32 + r;
    const float sc = rs_lds[ml] * mul;
    u16* drow = dst + (size_t)(m0 + ml) * ld + c0 + 8 * hf;
#pragma unroll
    for (int nt = 0; nt < 2; ++nt)
#pragma unroll
      for (int a = 0; a < 2; ++a) {
        float x[4], y[4];
#pragma unroll
        for (int e = 0; e < 4; ++e) { x[e] = acc[mt][nt][8 * a + e] * sc; y[e] = acc[mt][nt][8 * a + 4 + e] * sc; }
        if (SILU) {
#pragma unroll
          for (int e = 0; e < 4; ++e) { x[e] = silu_f(x[e]); y[e] = silu_f(y[e]); }
        }
        st8_pair_bf16(drow + nt * 32 + 16 * a, x, y);
      }
  }
}

DI void epi_rope(const Params& p, const f32x16 (&acc)[4][2], u16* dst, int ld, int c0, int nrep, int rep_stride, int m0, const float* rs_lds, float mul) {
  const int t = tid(), lane = t & 63, w = t >> 6, wm = w >> 2, r = lane & 31, hf = lane >> 5;
  f32x4 cs[2][4], sn[2][4];
#pragma unroll
  for (int g = 0; g < 4; ++g) {
    const size_t o_ = (size_t)(m0 + wm * 128 + r) * 32 + 8 * g + 4 * hf;
    cs[0][g] = *(const f32x4*)(p.RCOS + o_); sn[0][g] = *(const f32x4*)(p.RSIN + o_);
  }
#pragma unroll
  for (int mt = 0; mt < 4; ++mt) {
    const int ml = wm * 128 + mt * 32 + r;
    const int m = m0 + ml;
    const float sc = rs_lds[ml] * mul;
    if (mt + 1 < 4) {
#pragma unroll
      for (int g = 0; g < 4; ++g) {
        const size_t o_ = (size_t)(m + 32) * 32 + 8 * g + 4 * hf;
        cs[(mt + 1) & 1][g] = *(const f32x4*)(p.RCOS + o_); sn[(mt + 1) & 1][g] = *(const f32x4*)(p.RSIN + o_);
      }
    }
#pragma unroll
    for (int g = 0; g < 4; ++g) {
      const int j = 8 * g + 4 * hf;
      float o1[4], o2[4];
#pragma unroll
      for (int e = 0; e < 4; ++e) {
        const float x1 = acc[mt][0][4 * g + e] * sc, x2 = acc[mt][1][4 * g + e] * sc;
        o1[e] = x1 * cs[mt & 1][g][e] - x2 * sn[mt & 1][g][e];
        o2[e] = x2 * cs[mt & 1][g][e] + x1 * sn[mt & 1][g][e];
      }
      for (int rep = 0; rep < nrep; ++rep) {
        u16* d = dst + (size_t)m * ld + c0 + rep * rep_stride + j;
        st4_bf16(d, o1[0], o1[1], o1[2], o1[3]);
        st4_bf16(d + 32, o2[0], o2[1], o2[2], o2[3]);
      }
    }
  }
}

DI void inproj_tile(const Params& p, int l, int mi, int ni, char* lds) {
  const int m0 = mi * 256, n0 = ni * 256;
  const u16* A = p.XB + (size_t)m0 * DM;
  const u16* Bt = p.WinT + ((size_t)l * INWP + n0) * DM;
  float* rs = (float*)(lds + RS_OFF);
  f32x16 acc[4][2];
  const int wn = (tid() >> 6) & 3;
  {
    const int t = tid();
    __syncthreads();
    if (t < 256) {
      const f32x4* ps = (const f32x4*)(p.XSS + (size_t)(m0 + t) * 32);
      float sacc = 0.f;
#pragma unroll
      for (int i = 0; i < 8; ++i) { const f32x4 v = ps[i]; sacc += (v[0] + v[1]) + (v[2] + v[3]); }
      rs[t] = rsqrtf(sacc * (1.0f / DM) + EPS);
    }
  }
  if (n0 >= 2048 && n0 < 3072) {
    gemm_main<false, false>(A, DM, Bt, DM, DM, lds, acc, rs);
    epi_vt(acc, p.VAT, n0 - 2048, m0, rs);
  } else {
    gemm_main<true, false>(A, DM, Bt, DM, DM, lds, acc, rs);
    const int nb = n0 + wn * 64;
    if (nb < 1024) epi_row<false>(acc, p.QA, 1024, nb, m0, rs, QSCALE_A);
    else if (nb < 2048) epi_row<false>(acc, p.KA, 1024, nb - 1024, m0, rs, 1.0f);
    else if (nb < 4096) epi_row<true>(acc, p.ZG, 2048, nb - 3072, m0, rs, 1.0f);
    else if (nb < 4608) epi_row<false>(acc, p.CQ, 512, nb - 4096, m0, rs, 1.0f);
    else if (nb < 5120) epi_row<false>(acc, p.CKV, 512, nb - 4608, m0, rs, 1.0f);
    else if (nb < 6144) epi_row<true>(acc, p.ZG, 2048, 1024 + nb - 5120, m0, rs, 1.0f);
    else if (nb == 6144) epi_rope(p, acc, p.KB, 1536, 128, 8, 192, m0, rs, 1.0f);
  }
}

DI void lat_tile(const Params& p, int l, int T, char* lds) {
  float* rs = (float*)(lds + RS_OFF);
  f32x16 acc[4][2];
  const int wn = (tid() >> 6) & 3;
  if (T < 192) {
    const int mi = T & 31, ni = T >> 5, m0 = mi * 256, n0 = ni * 256;
    gemm_main<true, true>(p.CQ + (size_t)m0 * 512, 512, p.WuqT + ((size_t)l * 1536 + n0) * 512, 512, 512, lds, acc, rs);
    const int nb = n0 + wn * 64;
    if ((nb % 192) == 128) epi_rope(p, acc, p.QB, 1536, nb, 1, 0, m0, rs, QSCALE_B);
    else epi_row<false>(acc, p.QB, 1536, nb, m0, rs, QSCALE_B);
  } else {
    const int T2 = T - 192;
    const int mi = T2 & 31, ni = T2 >> 5, m0 = mi * 256, n0 = ni * 256;
    const u16* A = p.CKV + (size_t)m0 * 512;
    const u16* Bt = p.WukvT + ((size_t)l * 2048 + n0) * 512;
    if (ni >= 4) {
      gemm_main<false, true>(A, 512, Bt, 512, 512, lds, acc, rs);
      epi_vt(acc, p.VBT, n0 - 1024, m0, rs);
    } else {
      gemm_main<true, true>(A, 512, Bt, 512, 512, lds, acc, rs);
      const int nb = n0 + wn * 64;
      epi_row<false>(acc, p.KB, 1536, (nb >> 7) * 192 + (nb & 127), m0, rs, 1.0f);
    }
  }
}

DI void out_tile(const Params& p, int l, int mi, int ni, char* lds) {
  const int m0 = mi * 256, n0 = ni * 256;
  f32x16 acc[4][2];
  const float* xs = (l == 0) ? p.x : p.X;
  const int t = tid(), lane = t & 63, w = t >> 6, wm = w >> 2, wn = w & 3, r = lane & 31, hf = lane >> 5;
#pragma unroll
  for (int mt = 0; mt < 4; ++mt) {
    const float* xr = xs + (size_t)(m0 + wm * 128 + mt * 32 + r) * DM + n0 + wn * 64 + 4 * hf;
#pragma unroll
    for (int nt = 0; nt < 2; ++nt)
#pragma unroll
      for (int g = 0; g < 4; ++g) {
        const f32x4 v = *(const f32x4*)(xr + nt * 32 + 8 * g);
        acc[mt][nt][4 * g] = v[0]; acc[mt][nt][4 * g + 1] = v[1]; acc[mt][nt][4 * g + 2] = v[2]; acc[mt][nt][4 * g + 3] = v[3];
      }
  }
  gemm_main<true, false, false>(p.MIX + (size_t)m0 * 2048, 2048, p.WoutT + ((size_t)l * 2048 + n0) * 2048, 2048, 2048, lds, acc, nullptr);
#pragma unroll
  for (int mt = 0; mt < 4; ++mt) {
    const size_t rowoff = (size_t)(m0 + wm * 128 + mt * 32 + r) * DM + n0 + wn * 64 + 4 * hf;
    const size_t rowoffb = (size_t)(m0 + wm * 128 + mt * 32 + r) * DM + n0 + wn * 64 + 8 * hf;
    float pss = 0.f;
#pragma unroll
    for (int nt = 0; nt < 2; ++nt)
#pragma unroll
      for (int a = 0; a < 2; ++a) {
        float xq[2][4];
#pragma unroll
        for (int gg = 0; gg < 2; ++gg) {
          const int g = 2 * a + gg;
          f32x4 xo = {acc[mt][nt][4 * g], acc[mt][nt][4 * g + 1], acc[mt][nt][4 * g + 2], acc[mt][nt][4 * g + 3]};
          *(f32x4*)(p.X + rowoff + nt * 32 + 8 * g) = xo;
          xq[gg][0] = xo[0]; xq[gg][1] = xo[1]; xq[gg][2] = xo[2]; xq[gg][3] = xo[3];
          pss = fmaf(xo[0], xo[0], pss); pss = fmaf(xo[1], xo[1], pss); pss = fmaf(xo[2], xo[2], pss); pss = fmaf(xo[3], xo[3], pss);
        }
        st8_pair_bf16(p.XB + rowoffb + nt * 32 + 16 * a, xq[0], xq[1]);
      }
    pss = xhalf_sum(pss);
    if (hf == 0) p.XSS[(size_t)(m0 + wm * 128 + mt * 32 + r) * 32 + ni * 4 + wn] = pss;
  }
}

template <int DQK, int KROW, bool BIAS, bool MAPS2>
DI void attn_core(const int t, const u16* __restrict__ Q, int ldq, const u16* __restrict__ Kp, int ldk, const u16* __restrict__ Vt, int q0,
                  char* lds, const float* lut, float b31, f32x16 (&o)[4], float& l_out) {
  constexpr int KS = KROW * 2 + 16, NKC = KROW / 64, NKS = DQK / 16;
  const int lane = t & 63, w = t >> 6, r = lane & 31, hf = lane >> 5;
  const int wr = MAPS2 ? (w & 3) : w, map = MAPS2 ? (w >> 2) : 0;
  const int wq0 = q0 + 32 * wr, qrow = wq0 + r;
  bf16x8 qf[NKS];
#pragma unroll
  for (int ks = 0; ks < NKS; ++ks) qf[ks] = *(const bf16x8*)(Q + (size_t)qrow * ldq + map * DQK + 16 * ks + 8 * hf);
#pragma unroll
  for (int dt = 0; dt < 4; ++dt)
#pragma unroll
    for (int i = 0; i < 16; ++i) o[dt][i] = 0.f;
  float m_run = 0.f, l_run = 0.f;
  const int ntile = (q0 >> 6) + (MAPS2 ? 2 : 4);
  u32x4 kr[NKC], vr[2];
  const unsigned koff = (unsigned)(t >> 3) * (unsigned)ldk + (unsigned)(t & 7) * 8u;
  const unsigned voff = (unsigned)(t >> 3) * (unsigned)S + (unsigned)(t & 7) * 8u;
  char* const klds = lds + (t >> 3) * KS + (t & 7) * 16;
  char* const vlds = lds + AT_VOFF + (t >> 3) * VS + ((t & 7) >> 1) * 32 + (t & 1) * 8;
#define AT_LOAD(TT) do { const u16* kn_ = Kp + (size_t)((TT) << 6) * ldk; const u16* vn_ = Vt + ((TT) << 6); \
    _Pragma("unroll") for (int pi = 0; pi < 2; ++pi) vr[pi] = *(const u32x4*)(vn_ + (size_t)64 * pi * S + voff); \
    _Pragma("unroll") for (int pi = 0; pi < NKC; ++pi) kr[pi] = *(const u32x4*)(kn_ + 64 * pi + koff); } while (0)
#define AT_WRITE(BUF) do { char* kd_ = klds + (BUF) * AT_KBUF; char* vd_ = vlds + (BUF) * AT_VBUF; \
    _Pragma("unroll") for (int pi = 0; pi < NKC; ++pi) *(u32x4*)(kd_ + 128 * pi) = kr[pi]; \
    _Pragma("unroll") for (int pi = 0; pi < 2; ++pi) { char* d_ = vd_ + 64 * pi * VS; \
      u32x2 lo_ = {vr[pi][0], vr[pi][1]}, hi_ = {vr[pi][2], vr[pi][3]}; *(u32x2*)d_ = lo_; *(u32x2*)(d_ + 16) = hi_; } } while (0)
  AT_LOAD(0);
  __syncthreads();
  AT_WRITE(0);
  AT_LOAD(1);
  __syncthreads();
  f32x16 s[2];
#pragma nounroll
  for (int kt = 0; kt < ntile; ++kt) {
    if (kt + 1 < ntile) {
      AT_WRITE((kt + 1) & 1);
      if (kt + 2 < ntile) AT_LOAD(kt + 2);
    }
    const bool live = (kt << 6) <= wq0 + 31;
    if (live) {
      const int k0 = kt << 6;
      const bool far = BIAS && (wq0 - (k0 + 63) >= 128);
      const float init = (far ? b31 : 0.f) - m_run;
#pragma unroll
      for (int k2 = 0; k2 < 2; ++k2)
#pragma unroll
        for (int i = 0; i < 16; ++i) s[k2][i] = init;
      {
        constexpr int QBS = (NKS > 4) ? 2 : 4, NBT = NKS / QBS;
        bf16x8 kfb[2][QBS][2];
        const char* kbase = lds + (kt & 1) * AT_KBUF + r * KS + hf * 16 + map * (DQK * 2);
#pragma unroll
        for (int jq = 0; jq < QBS; ++jq)
#pragma unroll
          for (int k2 = 0; k2 < 2; ++k2) kfb[0][jq][k2] = *(const bf16x8*)(kbase + 32 * k2 * KS + jq * 32);
#pragma unroll
        for (int b = 0; b < NBT; ++b) {
          if (b + 1 < NBT) {
#pragma unroll
            for (int jq = 0; jq < QBS; ++jq)
#pragma unroll
              for (int k2 = 0; k2 < 2; ++k2) kfb[(b + 1) & 1][jq][k2] = *(const bf16x8*)(kbase + 32 * k2 * KS + ((b + 1) * QBS + jq) * 32);
          }
          __builtin_amdgcn_sched_barrier(0);
          __builtin_amdgcn_s_setprio(1);
#pragma unroll
          for (int jq = 0; jq < QBS; ++jq)
#pragma unroll
            for (int k2 = 0; k2 < 2; ++k2) s[k2] = MFMA32(kfb[b & 1][jq][k2], qf[b * QBS + jq], s[k2]);
          __builtin_amdgcn_s_setprio(0);
          __builtin_amdgcn_sched_barrier(0);
        }
      }
      if (BIAS && !far) {
#pragma unroll
        for (int k2 = 0; k2 < 2; ++k2)
#pragma unroll
          for (int i = 0; i < 16; ++i) {
            const int key = k0 + 32 * k2 + (i & 3) + 8 * (i >> 2) + 4 * hf;
            int d = qrow - key; d = d < 0 ? 0 : (d > 128 ? 128 : d);
            s[k2][i] += lut[d];
          }
      }
      if (k0 + 63 > wq0) {
#pragma unroll
        for (int k2 = 0; k2 < 2; ++k2)
#pragma unroll
          for (int i = 0; i < 16; ++i) {
            const int key = k0 + 32 * k2 + (i & 3) + 8 * (i >> 2) + 4 * hf;
            if (key > qrow) s[k2][i] = -INFINITY;
          }
      }
      float mx = s[0][0];
#pragma unroll
      for (int k2 = 0; k2 < 2; ++k2)
#pragma unroll
        for (int i = 0; i < 16; ++i) mx = fmaxf(mx, s[k2][i]);
      mx = xhalf_max(mx);
      if (__builtin_amdgcn_ballot_w64(kt == 0 || mx > RESCALE_THR)) {
        const float delta = (kt == 0) ? mx : fmaxf(mx, 0.f);
        const float alpha = __builtin_amdgcn_exp2f(-delta);
        m_run += delta;
        l_run *= alpha;
#pragma unroll
        for (int dt = 0; dt < 4; ++dt)
#pragma unroll
          for (int i = 0; i < 16; ++i) o[dt][i] *= alpha;
#pragma unroll
        for (int k2 = 0; k2 < 2; ++k2)
#pragma unroll
          for (int i = 0; i < 16; ++i) s[k2][i] -= delta;
      }
      float ps = 0.f;
#pragma unroll
      for (int k2 = 0; k2 < 2; ++k2)
#pragma unroll
        for (int i = 0; i < 16; ++i) { const float pv = __builtin_amdgcn_exp2f(s[k2][i]); s[k2][i] = pv; ps += pv; }
      l_run += ps;
      bf16x8 vfb[2][4];
      const char* vbase = lds + AT_VOFF + (kt & 1) * AT_VBUF + r * VS + hf * 16;
#pragma unroll
      for (int dt = 0; dt < 4; ++dt) vfb[0][dt] = *(const bf16x8*)(vbase + 32 * dt * VS);
#pragma unroll
      for (int bb = 0; bb < 4; ++bb) {
        const int k2 = bb >> 1, s2 = bb & 1;
        if (bb + 1 < 4) {
#pragma unroll
          for (int dt = 0; dt < 4; ++dt) vfb[(bb + 1) & 1][dt] = *(const bf16x8*)(vbase + 32 * dt * VS + (bb + 1) * 32);
        }
        u32x4 pp;
        pp[0] = pk_bf16(s[k2][8 * s2 + 0], s[k2][8 * s2 + 1]);
        pp[1] = pk_bf16(s[k2][8 * s2 + 2], s[k2][8 * s2 + 3]);
        pp[2] = pk_bf16(s[k2][8 * s2 + 4], s[k2][8 * s2 + 5]);
        pp[3] = pk_bf16(s[k2][8 * s2 + 6], s[k2][8 * s2 + 7]);
        const bf16x8 pf = __builtin_bit_cast(bf16x8, pp);
        __builtin_amdgcn_sched_barrier(0);
        __builtin_amdgcn_s_setprio(1);
#pragma unroll
        for (int dt = 0; dt < 4; ++dt) o[dt] = MFMA32(vfb[bb & 1][dt], pf, o[dt]);
        __builtin_amdgcn_s_setprio(0);
        __builtin_amdgcn_sched_barrier(0);
      }
    }
    __syncthreads();
  }
#undef AT_LOAD
#undef AT_WRITE
  l_out = xhalf_sum(l_run);
}

DI void diff_unit(const Params& p, const int t, int l, int h, int qb, char* lds) {
  float* lut = (float*)(lds + LUT_OFF);
  const int lane = t & 63, w = t >> 6, r = lane & 31, hf = lane >> 5, wr = w & 3, map = w >> 2;
  __syncthreads();
  if (t < 132) lut[t] = p.BLUT[h * 132 + (t > 128 ? 128 : t)];
  const float b31 = p.BLUT[h * 132 + 128];
  const int q0 = qb * 128, qrow = q0 + 32 * wr + r;
  f32x16 o[4]; float lsum;
  attn_core<64, 128, true, true>(t, p.QA + h * 128, 1024, p.KA + h * 128, 1024, p.VAT + (size_t)h * 128 * S, q0, lds, lut, b31, o, lsum);
  float* ex = (float*)lds + (wr * 64) * 64 + lane;
  if (map == 1) {
    const float inv = p.LAM[l] / lsum;
#pragma unroll
    for (int dt = 0; dt < 4; ++dt)
#pragma unroll
      for (int i = 0; i < 16; ++i) ex[(dt * 16 + i) * 64] = o[dt][i] * inv;
  }
  __syncthreads();
  if (map == 0) {
    float ss = 0.f;
    const float inv = 1.0f / lsum;
#pragma unroll
    for (int dt = 0; dt < 4; ++dt)
#pragma unroll
      for (int i = 0; i < 16; ++i) { const float d = o[dt][i] * inv - ex[(dt * 16 + i) * 64]; o[dt][i] = d; ss = fmaf(d, d, ss); }
    ss = xhalf_sum(ss);
    const float rstd = rsqrtf(ss * (1.0f / 128.0f) + EPS) * p.LAM[4 + l];
    const float* gs = p.subln_g + l * 128;
    f32x4 ggv[16]; u32x2 zv[16];
#pragma unroll
    for (int dt = 0; dt < 4; ++dt)
#pragma unroll
      for (int g = 0; g < 4; ++g) {
        const int dv = 32 * dt + 8 * g + 4 * hf;
        ggv[dt * 4 + g] = *(const f32x4*)(gs + dv);
        zv[dt * 4 + g] = *(const u32x2*)(p.ZG + (size_t)qrow * 2048 + h * 128 + dv);
      }
#pragma unroll
    for (int dt = 0; dt < 4; ++dt)
#pragma unroll
      for (int a = 0; a < 2; ++a) {
        float xy[2][4];
#pragma unroll
        for (int q2 = 0; q2 < 2; ++q2) {
          const int g = 2 * a + q2;
          const f32x4 gg = ggv[dt * 4 + g]; const u32x2 z = zv[dt * 4 + g];
          xy[q2][0] = o[dt][4 * g] * rstd * gg[0] * bf_lo(z[0]); xy[q2][1] = o[dt][4 * g + 1] * rstd * gg[1] * bf_hi(z[0]);
          xy[q2][2] = o[dt][4 * g + 2] * rstd * gg[2] * bf_lo(z[1]); xy[q2][3] = o[dt][4 * g + 3] * rstd * gg[3] * bf_hi(z[1]);
        }
        st8_pair_bf16(p.MIX + (size_t)qrow * 2048 + h * 128 + 32 * dt + 16 * a + 8 * hf, xy[0], xy[1]);
      }
  }
}

DI void mla_unit(const Params& p, const int t, int l, int h, int qb, char* lds) {
  const int lane = t & 63, w = t >> 6, r = lane & 31, hf = lane >> 5;
  const int q0 = qb * 256, qrow = q0 + 32 * w + r;
  f32x16 o[4]; float lsum;
  attn_core<192, 192, false, false>(t, p.QB + h * 192, 1536, p.KB + h * 192, 1536, p.VBT + (size_t)h * 128 * S, q0, lds, nullptr, 0.f, o, lsum);
  const float inv = 1.0f / lsum;
  u32x2 zv[16];
#pragma unroll
  for (int dt = 0; dt < 4; ++dt)
#pragma unroll
    for (int g = 0; g < 4; ++g) zv[dt * 4 + g] = *(const u32x2*)(p.ZG + (size_t)qrow * 2048 + 1024 + h * 128 + 32 * dt + 8 * g + 4 * hf);
#pragma unroll
  for (int dt = 0; dt < 4; ++dt)
#pragma unroll
    for (int a = 0; a < 2; ++a) {
      float xy[2][4];
#pragma unroll
      for (int q2 = 0; q2 < 2; ++q2) {
        const int g = 2 * a + q2;
        const u32x2 z = zv[dt * 4 + g];
        xy[q2][0] = o[dt][4 * g] * inv * bf_lo(z[0]); xy[q2][1] = o[dt][4 * g + 1] * inv * bf_hi(z[0]);
        xy[q2][2] = o[dt][4 * g + 2] * inv * bf_lo(z[1]); xy[q2][3] = o[dt][4 * g + 3] * inv * bf_hi(z[1]);
      }
      st8_pair_bf16(p.MIX + (size_t)qrow * 2048 + 1024 + h * 128 + 32 * dt + 16 * a + 8 * hf, xy[0], xy[1]);
    }
}

DI unsigned xcc_id() { return (unsigned)__builtin_amdgcn_s_getreg((3 << 11) | 20) & 7u; }

DI void phase_attn(const Params& p, int l, char* lds) {
  unsigned* qc = p.counters + 32 + l * 8;
  int* ubox = (int*)(lds + UBOX_OFF);
  const int myx = (int)xcc_id();
  int qi = 0;
  for (;;) {
    __syncthreads();
    if (tid() == 0) {
      int u = -1;
      while (qi < 8) {
        const int x = (myx + qi) & 7;
        const unsigned i = atomicAdd(qc + x, 1u);
        if (i < 96u) { u = x * 96 + (int)i; break; }
        ++qi;
      }
      *ubox = u;
    }
    __syncthreads();
    const int u = *ubox;
    if (u < 0) break;
    const int h = u / 96, i = u - h * 96;
    const int t = tid();
    if (i < 11) mla_unit(p, t, l, h, 31 - i, lds);
    else {
      const int k = i - 11, grp = k >> 2, pos = k & 3;
      if (grp < 21 && pos == 3) mla_unit(p, t, l, h, 20 - grp, lds);
      else diff_unit(p, t, l, h, 63 - (grp * 3 + pos), lds);
    }
  }
}

DI void kr_unit(const Params& p, int l, int mr, char* lds) {
  constexpr int RS2 = 528, TILE2 = 64 * RS2, STG2 = 2 * TILE2;
  const int t = tid(), lane = t & 63, w = t >> 6, r = lane & 31, hf = lane >> 5;
  const int m0 = mr * 64;
  const u16* A = p.XB + (size_t)m0 * DM;
  const u16* Bt = p.WinT + ((size_t)l * INWP + 6144) * DM;
  const unsigned goff = (unsigned)(t >> 3) * (unsigned)DM + (unsigned)(t & 7) * 8u;
  char* const wbase = lds + (t >> 3) * RS2 + (t & 7) * 16;
  u32x4 ra[4], rb[4];
  f32x16 acc[2][2];
#pragma unroll
  for (int mt = 0; mt < 2; ++mt)
#pragma unroll
    for (int nt = 0; nt < 2; ++nt)
#pragma unroll
      for (int i = 0; i < 16; ++i) acc[mt][nt][i] = 0.f;
#define KR_LOAD(SS) do { _Pragma("unroll") for (int j = 0; j < 4; ++j) { \
    ra[j] = *(const u32x4*)(A + (SS) * 256 + 64 * j + goff); rb[j] = *(const u32x4*)(Bt + (SS) * 256 + 64 * j + goff); } } while (0)
#define KR_WRITE(STG) do { char* a_ = wbase + (STG) * STG2; _Pragma("unroll") for (int j = 0; j < 4; ++j) { \
    *(u32x4*)(a_ + 128 * j) = ra[j]; *(u32x4*)(a_ + TILE2 + 128 * j) = rb[j]; } } while (0)
  KR_LOAD(0);
  __syncthreads();
  KR_WRITE(0);
  KR_LOAD(1);
  __syncthreads();
  const char* abase = lds + r * RS2 + 64 * w + hf * 16;
  const char* bbase = abase + TILE2;
#pragma nounroll
  for (int s = 0; s < 8; ++s) {
    const int st = (s & 1) * STG2;
    bf16x8 fa[2][2], fb[2][2];
#pragma unroll
    for (int ks = 0; ks < 2; ++ks)
#pragma unroll
      for (int i = 0; i < 2; ++i) {
        fa[ks][i] = *(const bf16x8*)(abase + st + i * 32 * RS2 + ks * 32);
        fb[ks][i] = *(const bf16x8*)(bbase + st + i * 32 * RS2 + ks * 32);
      }
#pragma unroll
    for (int ks = 0; ks < 2; ++ks)
#pragma unroll
      for (int mt = 0; mt < 2; ++mt)
#pragma unroll
        for (int nt = 0; nt < 2; ++nt) acc[mt][nt] = MFMA32(fb[ks][nt], fa[ks][mt], acc[mt][nt]);
    if (s + 1 < 8) KR_WRITE((s + 1) & 1);
    if (s + 2 < 8) KR_LOAD(s + 2);
    __syncthreads();
  }
#undef KR_LOAD
#undef KR_WRITE
  float* red = (float*)lds;
#pragma unroll
  for (int mt = 0; mt < 2; ++mt)
#pragma unroll
    for (int nt = 0; nt < 2; ++nt)
#pragma unroll
      for (int i = 0; i < 16; ++i) red[(w * 64 + mt * 32 + nt * 16 + i) * 64 + lane] = acc[mt][nt][i];
  __syncthreads();
  {
    const int mt = w >> 2, ig = w & 3;
    const int m = m0 + mt * 32 + r, j = 8 * ig + 4 * hf;
    float x1[4], x2[4];
#pragma unroll
    for (int e = 0; e < 4; ++e) {
      float a1 = 0.f, a2 = 0.f;
#pragma unroll
      for (int ww = 0; ww < 8; ++ww) {
        a1 += red[(ww * 64 + mt * 32 + 4 * ig + e) * 64 + lane];
        a2 += red[(ww * 64 + mt * 32 + 16 + 4 * ig + e) * 64 + lane];
      }
      x1[e] = a1; x2[e] = a2;
    }
    const f32x4* ps = (const f32x4*)(p.XSS + (size_t)m * 32);
    float sacc = 0.f;
#pragma unroll
    for (int i = 0; i < 8; ++i) { const f32x4 v = ps[i]; sacc += (v[0] + v[1]) + (v[2] + v[3]); }
    const float sc = rsqrtf(sacc * (1.0f / DM) + EPS);
    const f32x4 cs = *(const f32x4*)(p.RCOS + (size_t)m * 32 + j);
    const f32x4 sn = *(const f32x4*)(p.RSIN + (size_t)m * 32 + j);
    float o1[4], o2[4];
#pragma unroll
    for (int e = 0; e < 4; ++e) {
      const float y1 = x1[e] * sc, y2 = x2[e] * sc;
      o1[e] = y1 * cs[e] - y2 * sn[e];
      o2[e] = y2 * cs[e] + y1 * sn[e];
    }
#pragma unroll
    for (int rep = 0; rep < 8; ++rep) {
      u16* d = p.KB + (size_t)m * 1536 + 128 + rep * 192 + j;
      st4_bf16(d, o1[0], o1[1], o1[2], o1[3]);
      st4_bf16(d + 32, o2[0], o2[1], o2[2], o2[3]);
    }
  }
}

DI void phase_lat(const Params& p, int l, char* lds) {
  unsigned* ctr = p.counters + 4 + l;
  int* ubox = (int*)(lds + UBOX_OFF);
  for (;;) {
    __syncthreads();
    if (tid() == 0) *ubox = (int)atomicAdd(ctr, 1u);
    __syncthreads();
    const int u = *ubox;
    if (u >= 128 + 448) break;
    if (u < 128) kr_unit(p, l, u, lds); else lat_tile(p, l, u - 128, lds);
  }
}

DI void wt_tile(const float* __restrict__ W, int K, int N, int k0, int n0, const float* __restrict__ g, u16* __restrict__ dst, int nd0, char* lds) {
  float* tile = (float*)lds;
  const int t = tid();
  __syncthreads();
#pragma unroll
  for (int pi = 0; pi < 2; ++pi) {
    const int kk = (t >> 4) + 32 * pi, c4 = (t & 15) * 4;
    f32x4 v = *(const f32x4*)(W + (size_t)(k0 + kk) * N + n0 + c4);
    const float gg = g ? g[k0 + kk] : 1.0f;
    tile[kk * 65 + c4] = v[0] * gg; tile[kk * 65 + c4 + 1] = v[1] * gg; tile[kk * 65 + c4 + 2] = v[2] * gg; tile[kk * 65 + c4 + 3] = v[3] * gg;
  }
  __syncthreads();
  const int n = t >> 3, kc = (t & 7) * 8;
  u32x4 o0;
#pragma unroll
  for (int e = 0; e < 4; ++e) o0[e] = pk_bf16(tile[(kc + 2 * e) * 65 + n], tile[(kc + 2 * e + 1) * 65 + n]);
  u16* d = dst + (size_t)(nd0 + n) * K + k0 + kc;
  *(u32x4*)d = o0;
}

DI void sincos_d(float ang, float& c, float& s) {
  const double x = (double)ang;
  const double n = rint(x * 0.6366197723675814);
  const double rr = (x - n * 1.5707963267948966) - n * 6.123233995736766e-17;
  const int q = ((int)n) & 3;
  const double r2 = rr * rr;
  const double sn = rr * (1.0 + r2 * (-1.0 / 6 + r2 * (1.0 / 120 + r2 * (-1.0 / 5040 + r2 * (1.0 / 362880 + r2 * (-1.0 / 39916800 + r2 * (1.0 / 6227020800.0)))))));
  const double cs = 1.0 + r2 * (-0.5 + r2 * (1.0 / 24 + r2 * (-1.0 / 720 + r2 * (1.0 / 40320 + r2 * (-1.0 / 3628800 + r2 * (1.0 / 479001600.0 + r2 * (-1.0 / 87178291200.0)))))));
  double cc, ssn;
  if (q == 0) { cc = cs; ssn = sn; } else if (q == 1) { cc = -sn; ssn = cs; } else if (q == 2) { cc = -cs; ssn = -sn; } else { cc = sn; ssn = -cs; }
  c = (float)cc; s = (float)ssn;
}

DI void phase0(const Params& p, char* lds) {
  const int t = tid();
  constexpr int NJ0 = 4 * 32 * 97, NJ1 = 4 * 8 * 24, NJ2 = 4 * 8 * 32, NJ3 = 4 * 32 * 32;
  for (int T = blockIdx.x; T < NJ0 + NJ1 + NJ2 + NJ3; T += gridDim.x) {
    if (T < NJ0) {
      const int l = T / (32 * 97), rem = T - l * (32 * 97), kb = rem / 97, nb = rem - kb * 97;
      const int n0 = nb * 64;
      const int nd0 = n0 < 5120 ? n0 : (n0 == 5120 ? 6144 : n0 - 64);
      wt_tile(p.w_in + (size_t)l * DM * INW, DM, INW, kb * 64, n0, p.norm_g + l * DM, p.WinT + (size_t)l * INWP * DM, nd0, lds);
    } else if (T < NJ0 + NJ1) {
      const int T1 = T - NJ0, l = T1 / (8 * 24), rem = T1 - l * (8 * 24), kb = rem / 24, nb = rem - kb * 24;
      wt_tile(p.w_uq + (size_t)l * 512 * 1536, 512, 1536, kb * 64, nb * 64, p.qnorm_g + l * 512, p.WuqT + (size_t)l * 1536 * 512, nb * 64, lds);
    } else if (T < NJ0 + NJ1 + NJ2) {
      const int T1 = T - NJ0 - NJ1, l = T1 / (8 * 32), rem = T1 - l * (8 * 32), kb = rem / 32, nb = rem - kb * 32;
      const int hh = nb >> 2, wi = nb & 3;
      const int nd = (wi < 2) ? (hh * 128 + wi * 64) : (1024 + hh * 128 + (wi - 2) * 64);
      wt_tile(p.w_ukv + (size_t)l * 512 * 2048, 512, 2048, kb * 64, nb * 64, p.kvnorm_g + l * 512, p.WukvT + (size_t)l * 2048 * 512, nd, lds);
    } else {
      const int T1 = T - NJ0 - NJ1 - NJ2, l = T1 / (32 * 32), rem = T1 - l * (32 * 32), kb = rem / 32, nb = rem - kb * 32;
      wt_tile(p.w_out + (size_t)l * 2048 * 2048, 2048, 2048, kb * 64, nb * 64, nullptr, p.WoutT + (size_t)l * 2048 * 2048, nb * 64, lds);
    }
  }
  const int gtid = blockIdx.x * NTHREADS + t, gsz = gridDim.x * NTHREADS;
  for (int i = gtid; i < 4 * 192 * 256; i += gsz) {
    const int l = i / (192 * 256), rem = i - l * (192 * 256);
    u32x4 z = {0u, 0u, 0u, 0u};
    *(u32x4*)(p.WinT + ((size_t)l * INWP + INW) * DM + (size_t)rem * 8) = z;
  }
  for (int i = gtid; i < S * DM / 8; i += gsz) {
    const f32x4 a = *(const f32x4*)(p.x + (size_t)i * 8), b = *(const f32x4*)(p.x + (size_t)i * 8 + 4);
    u32x4 o = {pk_bf16(a[0], a[1]), pk_bf16(a[2], a[3]), pk_bf16(b[0], b[1]), pk_bf16(b[2], b[3])};
    *(u32x4*)(p.XB + (size_t)i * 8) = o;
    float q = (a[0] * a[0] + a[1] * a[1]) + (a[2] * a[2] + a[3] * a[3]) + (b[0] * b[0] + b[1] * b[1]) + (b[2] * b[2] + b[3] * b[3]);
    q += __shfl_xor(q, 1); q += __shfl_xor(q, 2); q += __shfl_xor(q, 4);
    if ((i & 7) == 0) p.XSS[i >> 3] = q;
  }
  for (int i = gtid; i < S * 32; i += gsz) {
    const int pos = i >> 5, j = i & 31;
    const float pw = (float)exp((double)((float)(2 * j) / 64.0f) * 9.210340371976184);
    const float inv = 1.0f / pw;
    const float ang = (float)pos * inv;
    float c, s; sincos_d(ang, c, s);
    p.RCOS[i] = c; p.RSIN[i] = s;
  }
  for (int i = gtid; i < 8 * 132; i += gsz) {
    const int h = i / 132, d = i - h * 132;
    const int n = d > 128 ? 128 : d;
    int bucket;
    if (n < 16) bucket = n;
    else {
      const float nf = (float)n;
      int lg = 16 + (int)(logf(nf / 16.0f) / 2.0794415416798357f * 16.0f);
      bucket = lg > 31 ? 31 : lg;
    }
    p.BLUT[i] = p.bias_tab[bucket * 8 + h] * LOG2E;
  }
  if (gtid < 4) {
    const float* lp = p.diff_lambda + gtid * 256;
    float s1 = 0.f, s2 = 0.f;
    for (int e = 0; e < 64; ++e) { s1 += lp[e] * lp[64 + e]; s2 += lp[128 + e] * lp[192 + e]; }
    p.LAM[gtid] = expf(s1) - expf(s2) + lambda_init(gtid);
    p.LAM[4 + gtid] = 1.0f - lambda_init(gtid);
  }
}

DI void phase_final(const Params& p) {
  const int t = tid(), lane = t & 63, w = t >> 6;
  for (int row = blockIdx.x * 8 + w; row < S; row += gridDim.x * 8) {
    const float* xr = p.X + (size_t)row * DM;
    f32x4 v[8];
    float ss = 0.f;
#pragma unroll
    for (int i = 0; i < 8; ++i) { v[i] = *(const f32x4*)(xr + i * 256 + lane * 4); ss += v[i][0] * v[i][0] + v[i][1] * v[i][1] + v[i][2] * v[i][2] + v[i][3] * v[i][3]; }
#pragma unroll
    for (int o = 1; o < 64; o <<= 1) ss += __shfl_xor(ss, o);
    const float rs = rsqrtf(ss * (1.0f / DM) + EPS);
#pragma unroll
    for (int i = 0; i < 8; ++i) {
      const f32x4 g = *(const f32x4*)(p.final_g + i * 256 + lane * 4);
      f32x4 o = {v[i][0] * rs * g[0], v[i][1] * rs * g[1], v[i][2] * rs * g[2], v[i][3] * rs * g[3]};
      *(f32x4*)(p.out + (size_t)row * DM + i * 256 + lane * 4) = o;
    }
  }
}

DI void run_phase(const Params& p, int ph, char* lds) {
#ifndef PHMASK
#define PHMASK 63
#endif
  if (ph == 0) { if (PHMASK & 1) phase0(p, lds); return; }
  if (ph == 17) { if (PHMASK & 2) phase_final(p); return; }
  const int l = (ph - 1) >> 2, sub = (ph - 1) & 3;
  if (sub == 0 && (PHMASK & 4)) {
    for (int T = blockIdx.x; T < 32 * 24; T += gridDim.x) inproj_tile(p, l, T & 31, T >> 5, lds);
  } else if (sub == 1 && (PHMASK & 8)) {
    phase_lat(p, l, lds);
  } else if (sub == 2 && (PHMASK & 16)) {
    phase_attn(p, l, lds);
  } else if (sub == 3 && (PHMASK & 32)) {
    for (int T = blockIdx.x; T < 32 * 8; T += gridDim.x) out_tile(p, l, T & 31, T >> 5, lds);
  }
}

#if ONE_LAUNCH
DI void grid_bar(unsigned* cw, unsigned xcc, unsigned nx, unsigned nxp, unsigned gen) {
  __syncthreads();
  if (tid() == 0) {
    const unsigned old = __hip_atomic_fetch_add(cw + 256 + 16 * xcc, 1u, __ATOMIC_RELAXED, __HIP_MEMORY_SCOPE_AGENT);
    if (old + 1u == nx * gen) {
      __builtin_amdgcn_fence(__ATOMIC_RELEASE, "agent");
      asm volatile("s_waitcnt vmcnt(0)" ::: "memory");
      __hip_atomic_fetch_add(cw + 512, 1u, __ATOMIC_RELAXED, __HIP_MEMORY_SCOPE_AGENT);
    }
    while (__hip_atomic_load(cw + 512, __ATOMIC_RELAXED, __HIP_MEMORY_SCOPE_AGENT) < nxp * gen) __builtin_amdgcn_s_sleep(4);
    __builtin_amdgcn_fence(__ATOMIC_ACQUIRE, "agent");
    asm volatile("s_waitcnt vmcnt(0)" ::: "memory");
  }
  __syncthreads();
}
__global__ void __launch_bounds__(NTHREADS, 2) fwd_kernel(Params p) {
  __shared__ __attribute__((aligned(16))) char lds[LDS_BYTES];
  cg::grid_group grid = cg::this_grid();
  unsigned* cw = p.counters;
  const unsigned xcc = xcc_id();
  if (tid() == 0) __hip_atomic_fetch_add(cw + 64 + 16 * xcc, 1u, __ATOMIC_RELAXED, __HIP_MEMORY_SCOPE_AGENT);
  phase0(p, lds);
  grid.sync();
  unsigned nx = 0, nxp = 0;
#pragma unroll
  for (int j = 0; j < 8; ++j) {
    const unsigned c = (unsigned)__builtin_amdgcn_readfirstlane((int)__hip_atomic_load(cw + 64 + 16 * j, __ATOMIC_RELAXED, __HIP_MEMORY_SCOPE_AGENT));
    nxp += (c != 0u) ? 1u : 0u;
    if ((unsigned)j == xcc) nx = c;
  }
  nx = (unsigned)__builtin_amdgcn_readfirstlane((int)nx);
  nxp = (unsigned)__builtin_amdgcn_readfirstlane((int)nxp);
  unsigned gen = 0;
#pragma nounroll
  for (int l = 0; l < DEPTH; ++l) {
    for (int T = blockIdx.x; T < 32 * 24; T += gridDim.x) inproj_tile(p, l, T & 31, T >> 5, lds);
    grid_bar(cw, xcc, nx, nxp, ++gen);
    phase_lat(p, l, lds);
    grid_bar(cw, xcc, nx, nxp, ++gen);
    phase_attn(p, l, lds);
    grid_bar(cw, xcc, nx, nxp, ++gen);
    for (int T = blockIdx.x; T < 32 * 8; T += gridDim.x) out_tile(p, l, T & 31, T >> 5, lds);
    grid_bar(cw, xcc, nx, nxp, ++gen);
  }
  phase_final(p);
}
#else
__global__ void __launch_bounds__(NTHREADS, 2) fwd_kernel(Params p, int ph) {
  __shared__ __attribute__((aligned(16))) char lds[LDS_BYTES];
  run_phase(p, ph, lds);
}
#endif

extern "C" void kernel_launch(void* const* d_in, const int* in_sizes, int n_in, void* d_out, int out_size, void* d_ws, size_t ws_size,
                              hipStream_t stream) {
  Params p{};
  p.x = (const float*)d_in[0]; p.norm_g = (const float*)d_in[1]; p.w_in = (const float*)d_in[2]; p.diff_lambda = (const float*)d_in[3];
  p.subln_g = (const float*)d_in[4]; p.bias_tab = (const float*)d_in[5]; p.qnorm_g = (const float*)d_in[6]; p.w_uq = (const float*)d_in[7];
  p.kvnorm_g = (const float*)d_in[8]; p.w_ukv = (const float*)d_in[9]; p.w_out = (const float*)d_in[10]; p.final_g = (const float*)d_in[11];
  p.out = (float*)d_out;
  char* ws = (char*)d_ws;
  size_t off = 0;
  auto take = [&](size_t bytes) { char* r = ws + off; off += (bytes + 255) & ~(size_t)255; return r; };
  p.counters = (unsigned*)take(4096);
  p.LAM = (float*)take(256);
  p.BLUT = (float*)take(8 * 132 * 4);
  p.RCOS = (float*)take((size_t)S * 32 * 4);
  p.RSIN = (float*)take((size_t)S * 32 * 4);
  p.WinT = (u16*)take((size_t)DEPTH * INWP * DM * 2);
  p.WuqT = (u16*)take((size_t)DEPTH * 1536 * 512 * 2);
  p.WukvT = (u16*)take((size_t)DEPTH * 2048 * 512 * 2);
  p.WoutT = (u16*)take((size_t)DEPTH * 2048 * 2048 * 2);
  p.X = (float*)take((size_t)S * DM * 4);
  p.XB = (u16*)take((size_t)S * DM * 2);
  p.QA = (u16*)take((size_t)S * 1024 * 2);
  p.KA = (u16*)take((size_t)S * 1024 * 2);
  p.VAT = (u16*)take((size_t)S * 1024 * 2);
  p.ZG = (u16*)take((size_t)S * 2048 * 2);
  p.CQ = (u16*)take((size_t)S * 512 * 2);
  p.CKV = (u16*)take((size_t)S * 512 * 2);
  p.KB = (u16*)take((size_t)S * 1536 * 2);
  p.QB = (u16*)take((size_t)S * 1536 * 2);
  p.VBT = (u16*)take((size_t)S * 1024 * 2);
  p.MIX = (u16*)take((size_t)S * 2048 * 2);
  p.STASH = (float*)take((size_t)512 * 64 * NTHREADS * 4);
  p.XSS = (float*)take((size_t)S * 32 * 4);

  static int grid_blocks = 0;
  if (!grid_blocks) {
    int dev = 0, cus = 0, per_cu = 0;
    hipGetDevice(&dev);
    hipDeviceGetAttribute(&cus, hipDeviceAttributeMultiprocessorCount, dev);
    hipOccupancyMaxActiveBlocksPerMultiprocessor(&per_cu, fwd_kernel, NTHREADS, 0);
    if (per_cu > 1) per_cu = 1;
    if (per_cu < 1) per_cu = 1;
    grid_blocks = cus * per_cu;
  }
  hipMemsetAsync(p.counters, 0, 4096, stream);
#if ONE_LAUNCH
  void* args[] = {&p};
  hipError_t e = hipLaunchCooperativeKernel((void*)fwd_kernel, dim3(grid_blocks), dim3(NTHREADS), args, 0, stream);
  if (e != hipSuccess) fprintf(stderr, "cooperative launch failed: %s (grid %d)\n", hipGetErrorString(e), grid_blocks);
#else
  for (int ph = 0; ph < 18; ++ph) fwd_kernel<<<grid_blocks, NTHREADS, 0, stream>>>(p, ph);
#endif
}
```

```cpp
#include <hip/hip_runtime.h>
#include <hip/hip_cooperative_groups.h>
#include <cstdio>
#include <cstdint>
namespace cg = cooperative_groups;

#ifndef ONE_LAUNCH
#define ONE_LAUNCH 1
#endif

#define DI __device__ __forceinline__
typedef unsigned short u16;
typedef short bf16x8 __attribute__((ext_vector_type(8)));
typedef short s16x4 __attribute__((ext_vector_type(4)));
typedef float f32x16 __attribute__((ext_vector_type(16)));
typedef float f32x4 __attribute__((ext_vector_type(4)));
typedef float f32x2 __attribute__((ext_vector_type(2)));
typedef unsigned u32x2 __attribute__((ext_vector_type(2)));
typedef unsigned u32x4 __attribute__((ext_vector_type(4)));
typedef __bf16 bf2_t __attribute__((ext_vector_type(2)));

constexpr int S = 8192, DM = 2048, DEPTH = 4;
constexpr int INW = 6208, INWP = 6400;
constexpr int NTHREADS = 512;
constexpr float EPS = 1e-6f;
constexpr float LOG2E = 1.4426950408889634f;
constexpr float QSCALE_A = 0.125f * 1.4426950408889634f;
constexpr float QSCALE_B = 0.07216878364870322f * 1.4426950408889634f;
constexpr float RESCALE_THR = 6.0f;

constexpr int GS = 144;
constexpr int G_TILE = 256 * GS;
constexpr int RS_OFF = 4 * G_TILE;
constexpr int LDS_BYTES = RS_OFF + 1024;
constexpr int AT_KBUF = 25600;
constexpr int AT_VOFF = 2 * AT_KBUF;
constexpr int VS = 144;
constexpr int AT_VBUF = 128 * VS;
constexpr int LUT_OFF = AT_VOFF + 2 * AT_VBUF;
constexpr int UBOX_OFF = LUT_OFF + 544;

struct Params {
  const float *x, *norm_g, *w_in, *diff_lambda, *subln_g, *bias_tab, *qnorm_g, *w_uq, *kvnorm_g, *w_ukv, *w_out, *final_g;
  float* out;
  u16 *WinT, *WuqT, *WukvT, *WoutT;
  float* X; u16* XB;
  u16 *QA, *KA, *VAT, *ZG, *CQ, *CKV, *KB, *QB, *VBT, *MIX;
  float *STASH, *RCOS, *RSIN, *BLUT, *LAM, *XSS;
  unsigned* counters;
};

DI unsigned pk_bf16(float lo, float hi) {
  f32x2 v = {lo, hi};
  bf2_t r = __builtin_convertvector(v, bf2_t);
  return __builtin_bit_cast(unsigned, r);
}
DI float bf_lo(unsigned u) { return __uint_as_float(u << 16); }
DI float bf_hi(unsigned u) { return __uint_as_float(u & 0xffff0000u); }
DI float silu_f(float z) { return z * __builtin_amdgcn_rcpf(1.0f + __builtin_amdgcn_exp2f(-z * LOG2E)); }
DI float lambda_init(int l) { return l == 0 ? 0.2f : (l == 1 ? 0.35550906759096926f : (l == 2 ? 0.47071301834358414f : 0.5560582041575661f)); }
#define MFMA32(a, b, c) __builtin_amdgcn_mfma_f32_32x32x16_bf16((a), (b), (c), 0, 0, 0)
DI float xhalf_max(float x) {
  u32x2 r = __builtin_amdgcn_permlane32_swap(__float_as_uint(x), __float_as_uint(x), false, false);
  return fmaxf(__uint_as_float(r[0]), __uint_as_float(r[1]));
}
DI float xhalf_sum(float x) {
  u32x2 r = __builtin_amdgcn_permlane32_swap(__float_as_uint(x), __float_as_uint(x), false, false);
  return __uint_as_float(r[0]) + __uint_as_float(r[1]);
}
DI int tid() { int t = threadIdx.x; asm volatile("" : "+v"(t)); return t; }

template <bool SWAP, bool SSQ, bool ZERO = true>
DI void gemm_main(const u16* __restrict__ A, int lda, const u16* __restrict__ Bt, int ldb, int K, char* lds,
                  f32x16 (&acc)[4][2], float* rs_lds) {
  const int t = tid(), lane = t & 63, w = t >> 6, wm = w >> 2, wn = w & 3;
  const int r = lane & 31, hf = lane >> 5;
  const int lr = t >> 3, lc = t & 7;
  const u16* ap = A + (size_t)lr * lda + lc * 8;
  const u16* bp = Bt + (size_t)lr * ldb + lc * 8;
  u32x4 ra[4], rb[4];
  float ssq[4] = {0.f, 0.f, 0.f, 0.f};
  if (ZERO) {
#pragma unroll
    for (int mt = 0; mt < 4; ++mt)
#pragma unroll
      for (int nt = 0; nt < 2; ++nt)
#pragma unroll
        for (int i = 0; i < 16; ++i) acc[mt][nt][i] = 0.f;
  }
  const int nk = K >> 6;
  char* const wbase = lds + lr * GS + lc * 16;
  const char* abase = lds + (wm * 128 + r) * GS + hf * 16;
  const char* bbase = lds + G_TILE + (wn * 64 + r) * GS + hf * 16;
#define G_LOAD(KT) do { const int k0_ = (KT) << 6; _Pragma("unroll") for (int p = 0; p < 4; ++p) { \
    ra[p] = *(const u32x4*)(ap + (size_t)(64 * p) * lda + k0_); rb[p] = *(const u32x4*)(bp + (size_t)(64 * p) * ldb + k0_); } } while (0)
#define G_WRITE(STG) do { char* a_ = wbase + (STG) * 2 * G_TILE; _Pragma("unroll") for (int p = 0; p < 4; ++p) { \
    *(u32x4*)(a_ + 64 * p * GS) = ra[p]; *(u32x4*)(a_ + G_TILE + 64 * p * GS) = rb[p]; \
    if (SSQ) { _Pragma("unroll") for (int e = 0; e < 4; ++e) { const float lo_ = bf_lo(ra[p][e]), hi_ = bf_hi(ra[p][e]); \
      ssq[p] = fmaf(lo_, lo_, ssq[p]); ssq[p] = fmaf(hi_, hi_, ssq[p]); } } } } while (0)
  G_LOAD(0);
  __syncthreads();
  G_WRITE(0);
  G_LOAD(1);
  __syncthreads();
#pragma nounroll
  for (int kt = 0; kt < nk; ++kt) {
    const int st = (kt & 1) * 2 * G_TILE;
    {
      bf16x8 fa[2][4], fb[2][2];
#pragma unroll
      for (int i = 0; i < 4; ++i) fa[0][i] = *(const bf16x8*)(abase + st + i * 32 * GS);
#pragma unroll
      for (int i = 0; i < 2; ++i) fb[0][i] = *(const bf16x8*)(bbase + st + i * 32 * GS);
#pragma unroll
      for (int ks = 0; ks < 4; ++ks) {
        if (ks + 1 < 4) {
#pragma unroll
          for (int i = 0; i < 4; ++i) fa[(ks + 1) & 1][i] = *(const bf16x8*)(abase + st + i * 32 * GS + (ks + 1) * 32);
#pragma unroll
          for (int i = 0; i < 2; ++i) fb[(ks + 1) & 1][i] = *(const bf16x8*)(bbase + st + i * 32 * GS + (ks + 1) * 32);
        }
        __builtin_amdgcn_sched_barrier(0);
        __builtin_amdgcn_s_setprio(1);
#pragma unroll
        for (int mt = 0; mt < 4; ++mt)
#pragma unroll
          for (int nt = 0; nt < 2; ++nt)
            acc[mt][nt] = SWAP ? MFMA32(fb[ks & 1][nt], fa[ks & 1][mt], acc[mt][nt]) : MFMA32(fa[ks & 1][mt], fb[ks & 1][nt], acc[mt][nt]);
        __builtin_amdgcn_s_setprio(0);
        __builtin_amdgcn_sched_barrier(0);
      }
    }
    if (kt + 1 < nk) G_WRITE((kt + 1) & 1);
    if (kt + 2 < nk) G_LOAD(kt + 2);
    __syncthreads();
  }
#undef G_LOAD
#undef G_WRITE
  if (SSQ) {
    const float invk = 1.0f / (float)K;
#pragma unroll
    for (int p = 0; p < 4; ++p) {
      float v = ssq[p];
      v += __shfl_xor(v, 1); v += __shfl_xor(v, 2); v += __shfl_xor(v, 4);
      if (lc == 0) rs_lds[lr + 64 * p] = rsqrtf(v * invk + EPS);
    }
    __syncthreads();
  }
}

DI void st8_pair_bf16(u16* dst, const float (&x)[4], const float (&y)[4]) {
  unsigned x0 = pk_bf16(x[0], x[1]), x1 = pk_bf16(x[2], x[3]), y0 = pk_bf16(y[0], y[1]), y1 = pk_bf16(y[2], y[3]);
  const u32x2 r0 = __builtin_amdgcn_permlane32_swap(x0, y0, false, false);
  const u32x2 r1 = __builtin_amdgcn_permlane32_swap(x1, y1, false, false);
  u32x4 v = {r0[0], r1[0], r0[1], r1[1]};
  *(u32x4*)dst = v;
}
DI void st4_bf16(u16* dst, float a, float b, float c, float d) { u32x2 v = {pk_bf16(a, b), pk_bf16(c, d)}; *(u32x2*)dst = v; }

DI void epi_vt(const f32x16 (&acc)[4][2], u16* VT, int vrow0, int m0, const float* rs_lds) {
  const int t = tid(), lane = t & 63, w = t >> 6, wm = w >> 2, wn = w & 3, r = lane & 31, hf = lane >> 5;
#pragma unroll
  for (int mt = 0; mt < 4; ++mt)
#pragma unroll
    for (int a = 0; a < 2; ++a) {
      const int mlx = wm * 128 + mt * 32 + 16 * a + 4 * hf;
      const f32x4 rsx = *(const f32x4*)(rs_lds + mlx), rsy = *(const f32x4*)(rs_lds + mlx + 8);
#pragma unroll
      for (int nt = 0; nt < 2; ++nt) {
        float x[4], y[4];
#pragma unroll
        for (int e = 0; e < 4; ++e) { x[e] = acc[mt][nt][8 * a + e] * rsx[e]; y[e] = acc[mt][nt][8 * a + 4 + e] * rsy[e]; }
        st8_pair_bf16(VT + (size_t)(vrow0 + wn * 64 + nt * 32 + r) * S + m0 + wm * 128 + mt * 32 + 16 * a + 8 * hf, x, y);
      }
    }
}

template <bool SILU>
DI void epi_row(const f32x16 (&acc)[4][2], u16* dst, int ld, int c0, int m0, const float* rs_lds, float mul) {
  const int t = tid(), lane = t & 63, w = t >> 6, wm = w >> 2, r = lane & 31, hf = lane >> 5;
#pragma unroll
  for (int mt = 0; mt < 4; ++mt) {
    const int ml = wm * 128 + mt * 32 + r;
    const float sc = rs_lds[ml] * mul;
    u16* drow = dst + (size_t)(m0 + ml) * ld + c0 + 8 * hf;
#pragma unroll
    for (int nt = 0; nt < 2; ++nt)
#pragma unroll
      for (int a = 0; a < 2; ++a) {
        float x[4], y[4];
#pragma unroll
        for (int e = 0; e < 4; ++e) { x[e] = acc[mt][nt][8 * a + e] * sc; y[e] = acc[mt][nt][8 * a + 4 + e] * sc; }
        if (SILU) {
#pragma unroll
          for (int e = 0; e < 4; ++e) { x[e] = silu_f(x[e]); y[e] = silu_f(y[e]); }
        }
        st8_pair_bf16(drow + nt * 32 + 16 * a, x, y);
      }
  }
}

DI void epi_rope(const Params& p, const f32x16 (&acc)[4][2], u16* dst, int ld, int c0, int nrep, int rep_stride, int m0, const float* rs_lds, float mul) {
  const int t = tid(), lane = t & 63, w = t >> 6, wm = w >> 2, r = lane & 31, hf = lane >> 5;
  f32x4 cs[2][4], sn[2][4];
#pragma unroll
  for (int g = 0; g < 4; ++g) {
    const size_t o_ = (size_t)(m0 + wm * 128 + r) * 32 + 8 * g + 4 * hf;
    cs[0][g] = *(const f32x4*)(p.RCOS + o_); sn[0][g] = *(const f32x4*)(p.RSIN + o_);
  }
#pragma unroll
  for (int mt = 0; mt < 4; ++mt) {
    const int ml = wm * 128 + mt * 32 + r;
    const int m = m0 + ml;
    const float sc = rs_lds[ml] * mul;
    if (mt + 1 < 4) {
#pragma unroll
      for (int g = 0; g < 4; ++g) {
        const size_t o_ = (size_t)(m + 32) * 32 + 8 * g + 4 * hf;
        cs[(mt + 1) & 1][g] = *(const f32x4*)(p.RCOS + o_); sn[(mt + 1) & 1][g] = *(const f32x4*)(p.RSIN + o_);
      }
    }
#pragma unroll
    for (int a = 0; a < 2; ++a) {
      float o1[2][4], o2[2][4];
#pragma unroll
      for (int q2 = 0; q2 < 2; ++q2) {
        const int g = 2 * a + q2;
#pragma unroll
        for (int e = 0; e < 4; ++e) {
          const float x1 = acc[mt][0][4 * g + e] * sc, x2 = acc[mt][1][4 * g + e] * sc;
          o1[q2][e] = x1 * cs[mt & 1][g][e] - x2 * sn[mt & 1][g][e];
          o2[q2][e] = x2 * cs[mt & 1][g][e] + x1 * sn[mt & 1][g][e];
        }
      }
      for (int rep = 0; rep < nrep; ++rep) {
        u16* d = dst + (size_t)m * ld + c0 + rep * rep_stride + 16 * a + 8 * hf;
        st8_pair_bf16(d, o1[0], o1[1]);
        st8_pair_bf16(d + 32, o2[0], o2[1]);
      }
    }
  }
}

DI void inproj_tile(const Params& p, int l, int mi, int ni, char* lds) {
  const int m0 = mi * 256, n0 = ni * 256;
  const u16* A = p.XB + (size_t)m0 * DM;
  const u16* Bt = p.WinT + ((size_t)l * INWP + n0) * DM;
  float* rs = (float*)(lds + RS_OFF);
  f32x16 acc[4][2];
  const int wn = (tid() >> 6) & 3;
  {
    const int t = tid();
    __syncthreads();
    if (t < 256) {
      const f32x4* ps = (const f32x4*)(p.XSS + (size_t)(m0 + t) * 32);
      float sacc = 0.f;
#pragma unroll
      for (int i = 0; i < 8; ++i) { const f32x4 v = ps[i]; sacc += (v[0] + v[1]) + (v[2] + v[3]); }
      rs[t] = rsqrtf(sacc * (1.0f / DM) + EPS);
    }
  }
  if (n0 >= 2048 && n0 < 3072) {
    gemm_main<false, false>(A, DM, Bt, DM, DM, lds, acc, rs);
    epi_vt(acc, p.VAT, n0 - 2048, m0, rs);
  } else {
    gemm_main<true, false>(A, DM, Bt, DM, DM, lds, acc, rs);
    const int nb = n0 + wn * 64;
    if (nb < 1024) epi_row<false>(acc, p.QA, 1024, nb, m0, rs, QSCALE_A);
    else if (nb < 2048) epi_row<false>(acc, p.KA, 1024, nb - 1024, m0, rs, 1.0f);
    else if (nb < 4096) epi_row<true>(acc, p.ZG, 2048, nb - 3072, m0, rs, 1.0f);
    else if (nb < 4608) epi_row<false>(acc, p.CQ, 512, nb - 4096, m0, rs, 1.0f);
    else if (nb < 5120) epi_row<false>(acc, p.CKV, 512, nb - 4608, m0, rs, 1.0f);
    else if (nb < 6144) epi_row<true>(acc, p.ZG, 2048, 1024 + nb - 5120, m0, rs, 1.0f);
    else if (nb == 6144) epi_rope(p, acc, p.KB, 1536, 128, 8, 192, m0, rs, 1.0f);
  }
}

DI void lat_tile(const Params& p, int l, int T, char* lds) {
  float* rs = (float*)(lds + RS_OFF);
  f32x16 acc[4][2];
  const int wn = (tid() >> 6) & 3;
  if (T < 192) {
    const int mi = T & 31, ni = T >> 5, m0 = mi * 256, n0 = ni * 256;
    gemm_main<true, true>(p.CQ + (size_t)m0 * 512, 512, p.WuqT + ((size_t)l * 1536 + n0) * 512, 512, 512, lds, acc, rs);
    const int nb = n0 + wn * 64;
    if ((nb % 192) == 128) epi_rope(p, acc, p.QB, 1536, nb, 1, 0, m0, rs, QSCALE_B);
    else epi_row<false>(acc, p.QB, 1536, nb, m0, rs, QSCALE_B);
  } else {
    const int T2 = T - 192;
    const int mi = T2 & 31, ni = T2 >> 5, m0 = mi * 256, n0 = ni * 256;
    const u16* A = p.CKV + (size_t)m0 * 512;
    const u16* Bt = p.WukvT + ((size_t)l * 2048 + n0) * 512;
    if (ni >= 4) {
      gemm_main<false, true>(A, 512, Bt, 512, 512, lds, acc, rs);
      epi_vt(acc, p.VBT, n0 - 1024, m0, rs);
    } else {
      gemm_main<true, true>(A, 512, Bt, 512, 512, lds, acc, rs);
      const int nb = n0 + wn * 64;
      epi_row<false>(acc, p.KB, 1536, (nb >> 7) * 192 + (nb & 127), m0, rs, 1.0f);
    }
  }
}

DI void out_tile(const Params& p, int l, int mi, int ni, char* lds) {
  const int m0 = mi * 256, n0 = ni * 256;
  f32x16 acc[4][2];
  const float* xs = (l == 0) ? p.x : p.X;
  const int t = tid(), lane = t & 63, w = t >> 6, wm = w >> 2, wn = w & 3, r = lane & 31, hf = lane >> 5;
#pragma unroll
  for (int mt = 0; mt < 4; ++mt) {
    const float* xr = xs + (size_t)(m0 + wm * 128 + mt * 32 + r) * DM + n0 + wn * 64 + 4 * hf;
#pragma unroll
    for (int nt = 0; nt < 2; ++nt)
#pragma unroll
      for (int g = 0; g < 4; ++g) {
        const f32x4 v = *(const f32x4*)(xr + nt * 32 + 8 * g);
        acc[mt][nt][4 * g] = v[0]; acc[mt][nt][4 * g + 1] = v[1]; acc[mt][nt][4 * g + 2] = v[2]; acc[mt][nt][4 * g + 3] = v[3];
      }
  }
  gemm_main<true, false, false>(p.MIX + (size_t)m0 * 2048, 2048, p.WoutT + ((size_t)l * 2048 + n0) * 2048, 2048, 2048, lds, acc, nullptr);
#pragma unroll
  for (int mt = 0; mt < 4; ++mt) {
    const size_t rowoff = (size_t)(m0 + wm * 128 + mt * 32 + r) * DM + n0 + wn * 64 + 4 * hf;
    const size_t rowoffb = (size_t)(m0 + wm * 128 + mt * 32 + r) * DM + n0 + wn * 64 + 8 * hf;
    float pss = 0.f;
#pragma unroll
    for (int nt = 0; nt < 2; ++nt)
#pragma unroll
      for (int a = 0; a < 2; ++a) {
        float xq[2][4];
#pragma unroll
        for (int gg = 0; gg < 2; ++gg) {
          const int g = 2 * a + gg;
          f32x4 xo = {acc[mt][nt][4 * g], acc[mt][nt][4 * g + 1], acc[mt][nt][4 * g + 2], acc[mt][nt][4 * g + 3]};
          *(f32x4*)(p.X + rowoff + nt * 32 + 8 * g) = xo;
          xq[gg][0] = xo[0]; xq[gg][1] = xo[1]; xq[gg][2] = xo[2]; xq[gg][3] = xo[3];
          pss = fmaf(xo[0], xo[0], pss); pss = fmaf(xo[1], xo[1], pss); pss = fmaf(xo[2], xo[2], pss); pss = fmaf(xo[3], xo[3], pss);
        }
        st8_pair_bf16(p.XB + rowoffb + nt * 32 + 16 * a, xq[0], xq[1]);
      }
    pss = xhalf_sum(pss);
    if (hf == 0) p.XSS[(size_t)(m0 + wm * 128 + mt * 32 + r) * 32 + ni * 4 + wn] = pss;
  }
}

template <int DQK, int KROW, bool BIAS, bool MAPS2>
DI void attn_core(const int t, const u16* __restrict__ Q, int ldq, const u16* __restrict__ Kp, int ldk, const u16* __restrict__ Vt, int q0,
                  char* lds, const float* lut, float b31, f32x16 (&o)[4], float& l_out) {
  constexpr int KS = KROW * 2 + 16, NKC = KROW / 64, NKS = DQK / 16;
  const int lane = t & 63, w = t >> 6, r = lane & 31, hf = lane >> 5;
  const int wr = MAPS2 ? (w & 3) : w, map = MAPS2 ? (w >> 2) : 0;
  const int wq0 = q0 + 32 * wr, qrow = wq0 + r;
  bf16x8 qf[NKS];
#pragma unroll
  for (int ks = 0; ks < NKS; ++ks) qf[ks] = *(const bf16x8*)(Q + (size_t)qrow * ldq + map * DQK + 16 * ks + 8 * hf);
#pragma unroll
  for (int dt = 0; dt < 4; ++dt)
#pragma unroll
    for (int i = 0; i < 16; ++i) o[dt][i] = 0.f;
  float m_run = 0.f, l_run = 0.f;
  const int ntile = (q0 >> 6) + (MAPS2 ? 2 : 4);
  u32x4 kr[NKC], vr[2];
  const unsigned koff = (unsigned)(t >> 3) * (unsigned)ldk + (unsigned)(t & 7) * 8u;
  const unsigned voff = (unsigned)(t >> 3) * (unsigned)S + (unsigned)(t & 7) * 8u;
  char* const klds = lds + (t >> 3) * KS + (t & 7) * 16;
  char* const vlds = lds + AT_VOFF + (t >> 3) * VS + ((t & 7) >> 1) * 32 + (t & 1) * 8;
#define AT_LOAD(TT) do { const u16* kn_ = Kp + (size_t)((TT) << 6) * ldk; const u16* vn_ = Vt + ((TT) << 6); \
    _Pragma("unroll") for (int pi = 0; pi < 2; ++pi) vr[pi] = *(const u32x4*)(vn_ + (size_t)64 * pi * S + voff); \
    _Pragma("unroll") for (int pi = 0; pi < NKC; ++pi) kr[pi] = *(const u32x4*)(kn_ + 64 * pi + koff); } while (0)
#define AT_WRITE(BUF) do { char* kd_ = klds + (BUF) * AT_KBUF; char* vd_ = vlds + (BUF) * AT_VBUF; \
    _Pragma("unroll") for (int pi = 0; pi < NKC; ++pi) *(u32x4*)(kd_ + 128 * pi) = kr[pi]; \
    _Pragma("unroll") for (int pi = 0; pi < 2; ++pi) { char* d_ = vd_ + 64 * pi * VS; \
      u32x2 lo_ = {vr[pi][0], vr[pi][1]}, hi_ = {vr[pi][2], vr[pi][3]}; *(u32x2*)d_ = lo_; *(u32x2*)(d_ + 16) = hi_; } } while (0)
  AT_LOAD(0);
  __syncthreads();
  AT_WRITE(0);
  AT_LOAD(1);
  __syncthreads();
  f32x16 s[2];
#pragma nounroll
  for (int kt = 0; kt < ntile; ++kt) {
    if (kt + 1 < ntile) {
      AT_WRITE((kt + 1) & 1);
      if (kt + 2 < ntile) AT_LOAD(kt + 2);
    }
    const bool live = (kt << 6) <= wq0 + 31;
    if (live) {
      const int k0 = kt << 6;
      const bool far = BIAS && (wq0 - (k0 + 63) >= 128);
      const float init = (far ? b31 : 0.f) - m_run;
#pragma unroll
      for (int k2 = 0; k2 < 2; ++k2)
#pragma unroll
        for (int i = 0; i < 16; ++i) s[k2][i] = init;
      {
        constexpr int QBS = (NKS > 4) ? 2 : 4, NBT = NKS / QBS;
        bf16x8 kfb[2][QBS][2];
        const char* kbase = lds + (kt & 1) * AT_KBUF + r * KS + hf * 16 + map * (DQK * 2);
#pragma unroll
        for (int jq = 0; jq < QBS; ++jq)
#pragma unroll
          for (int k2 = 0; k2 < 2; ++k2) kfb[0][jq][k2] = *(const bf16x8*)(kbase + 32 * k2 * KS + jq * 32);
#pragma unroll
        for (int b = 0; b < NBT; ++b) {
          if (b + 1 < NBT) {
#pragma unroll
            for (int jq = 0; jq < QBS; ++jq)
#pragma unroll
              for (int k2 = 0; k2 < 2; ++k2) kfb[(b + 1) & 1][jq][k2] = *(const bf16x8*)(kbase + 32 * k2 * KS + ((b + 1) * QBS + jq) * 32);
          }
          __builtin_amdgcn_sched_barrier(0);
          __builtin_amdgcn_s_setprio(1);
#pragma unroll
          for (int jq = 0; jq < QBS; ++jq)
#pragma unroll
            for (int k2 = 0; k2 < 2; ++k2) s[k2] = MFMA32(kfb[b & 1][jq][k2], qf[b * QBS + jq], s[k2]);
          __builtin_amdgcn_s_setprio(0);
          __builtin_amdgcn_sched_barrier(0);
        }
      }
      if (BIAS && !far) {
#pragma unroll
        for (int k2 = 0; k2 < 2; ++k2)
#pragma unroll
          for (int i = 0; i < 16; ++i) {
            const int key = k0 + 32 * k2 + (i & 3) + 8 * (i >> 2) + 4 * hf;
            int d = qrow - key; d = d < 0 ? 0 : (d > 128 ? 128 : d);
            s[k2][i] += lut[d];
          }
      }
      if (k0 + 63 > wq0) {
#pragma unroll
        for (int k2 = 0; k2 < 2; ++k2)
#pragma unroll
          for (int i = 0; i < 16; ++i) {
            const int key = k0 + 32 * k2 + (i & 3) + 8 * (i >> 2) + 4 * hf;
            if (key > qrow) s[k2][i] = -INFINITY;
          }
      }
      float mx = s[0][0];
#pragma unroll
      for (int k2 = 0; k2 < 2; ++k2)
#pragma unroll
        for (int i = 0; i < 16; ++i) mx = fmaxf(mx, s[k2][i]);
      mx = xhalf_max(mx);
      if (__builtin_amdgcn_ballot_w64(kt == 0 || mx > RESCALE_THR)) {
        const float delta = (kt == 0) ? mx : fmaxf(mx, 0.f);
        const float alpha = __builtin_amdgcn_exp2f(-delta);
        m_run += delta;
        l_run *= alpha;
#pragma unroll
        for (int dt = 0; dt < 4; ++dt)
#pragma unroll
          for (int i = 0; i < 16; ++i) o[dt][i] *= alpha;
#pragma unroll
        for (int k2 = 0; k2 < 2; ++k2)
#pragma unroll
          for (int i = 0; i < 16; ++i) s[k2][i] -= delta;
      }
      float ps = 0.f;
#pragma unroll
      for (int k2 = 0; k2 < 2; ++k2)
#pragma unroll
        for (int i = 0; i < 16; ++i) { const float pv = __builtin_amdgcn_exp2f(s[k2][i]); s[k2][i] = pv; ps += pv; }
      l_run += ps;
      bf16x8 vfb[2][4];
      const char* vbase = lds + AT_VOFF + (kt & 1) * AT_VBUF + r * VS + hf * 16;
#pragma unroll
      for (int dt = 0; dt < 4; ++dt) vfb[0][dt] = *(const bf16x8*)(vbase + 32 * dt * VS);
#pragma unroll
      for (int bb = 0; bb < 4; ++bb) {
        const int k2 = bb >> 1, s2 = bb & 1;
        if (bb + 1 < 4) {
#pragma unroll
          for (int dt = 0; dt < 4; ++dt) vfb[(bb + 1) & 1][dt] = *(const bf16x8*)(vbase + 32 * dt * VS + (bb + 1) * 32);
        }
        u32x4 pp;
        pp[0] = pk_bf16(s[k2][8 * s2 + 0], s[k2][8 * s2 + 1]);
        pp[1] = pk_bf16(s[k2][8 * s2 + 2], s[k2][8 * s2 + 3]);
        pp[2] = pk_bf16(s[k2][8 * s2 + 4], s[k2][8 * s2 + 5]);
        pp[3] = pk_bf16(s[k2][8 * s2 + 6], s[k2][8 * s2 + 7]);
        const bf16x8 pf = __builtin_bit_cast(bf16x8, pp);
        __builtin_amdgcn_sched_barrier(0);
        __builtin_amdgcn_s_setprio(1);
#pragma unroll
        for (int dt = 0; dt < 4; ++dt) o[dt] = MFMA32(vfb[bb & 1][dt], pf, o[dt]);
        __builtin_amdgcn_s_setprio(0);
        __builtin_amdgcn_sched_barrier(0);
      }
    }
    __syncthreads();
  }
#undef AT_LOAD
#undef AT_WRITE
  l_out = xhalf_sum(l_run);
}

DI void diff_unit(const Params& p, const int t, int l, int h, int qb, char* lds) {
  float* lut = (float*)(lds + LUT_OFF);
  const int lane = t & 63, w = t >> 6, r = lane & 31, hf = lane >> 5, wr = w & 3, map = w >> 2;
  __syncthreads();
  if (t < 132) lut[t] = p.BLUT[h * 132 + (t > 128 ? 128 : t)];
  const float b31 = p.BLUT[h * 132 + 128];
  const int q0 = qb * 128, qrow = q0 + 32 * wr + r;
  f32x16 o[4]; float lsum;
  attn_core<64, 128, true, true>(t, p.QA + h * 128, 1024, p.KA + h * 128, 1024, p.VAT + (size_t)h * 128 * S, q0, lds, lut, b31, o, lsum);
  float* ex = (float*)lds + (wr * 64) * 64 + lane;
  if (map == 1) {
    const float inv = p.LAM[l] / lsum;
#pragma unroll
    for (int dt = 0; dt < 4; ++dt)
#pragma unroll
      for (int i = 0; i < 16; ++i) ex[(dt * 16 + i) * 64] = o[dt][i] * inv;
  }
  __syncthreads();
  if (map == 0) {
    float ss = 0.f;
    const float inv = 1.0f / lsum;
#pragma unroll
    for (int dt = 0; dt < 4; ++dt)
#pragma unroll
      for (int i = 0; i < 16; ++i) { const float d = o[dt][i] * inv - ex[(dt * 16 + i) * 64]; o[dt][i] = d; ss = fmaf(d, d, ss); }
    ss = xhalf_sum(ss);
    const float rstd = rsqrtf(ss * (1.0f / 128.0f) + EPS) * p.LAM[4 + l];
    const float* gs = p.subln_g + l * 128;
    f32x4 ggv[16]; u32x2 zv[16];
#pragma unroll
    for (int dt = 0; dt < 4; ++dt)
#pragma unroll
      for (int g = 0; g < 4; ++g) {
        const int dv = 32 * dt + 8 * g + 4 * hf;
        ggv[dt * 4 + g] = *(const f32x4*)(gs + dv);
        zv[dt * 4 + g] = *(const u32x2*)(p.ZG + (size_t)qrow * 2048 + h * 128 + dv);
      }
#pragma unroll
    for (int dt = 0; dt < 4; ++dt)
#pragma unroll
      for (int a = 0; a < 2; ++a) {
        float xy[2][4];
#pragma unroll
        for (int q2 = 0; q2 < 2; ++q2) {
          const int g = 2 * a + q2;
          const f32x4 gg = ggv[dt * 4 + g]; const u32x2 z = zv[dt * 4 + g];
          xy[q2][0] = o[dt][4 * g] * rstd * gg[0] * bf_lo(z[0]); xy[q2][1] = o[dt][4 * g + 1] * rstd * gg[1] * bf_hi(z[0]);
          xy[q2][2] = o[dt][4 * g + 2] * rstd * gg[2] * bf_lo(z[1]); xy[q2][3] = o[dt][4 * g + 3] * rstd * gg[3] * bf_hi(z[1]);
        }
        st8_pair_bf16(p.MIX + (size_t)qrow * 2048 + h * 128 + 32 * dt + 16 * a + 8 * hf, xy[0], xy[1]);
      }
  }
}

DI void mla_unit(const Params& p, const int t, int l, int h, int qb, char* lds) {
  const int lane = t & 63, w = t >> 6, r = lane & 31, hf = lane >> 5;
  const int q0 = qb * 256, qrow = q0 + 32 * w + r;
  f32x16 o[4]; float lsum;
  attn_core<192, 192, false, false>(t, p.QB + h * 192, 1536, p.KB + h * 192, 1536, p.VBT + (size_t)h * 128 * S, q0, lds, nullptr, 0.f, o, lsum);
  const float inv = 1.0f / lsum;
  u32x2 zv[16];
#pragma unroll
  for (int dt = 0; dt < 4; ++dt)
#pragma unroll
    for (int g = 0; g < 4; ++g) zv[dt * 4 + g] = *(const u32x2*)(p.ZG + (size_t)qrow * 2048 + 1024 + h * 128 + 32 * dt + 8 * g + 4 * hf);
#pragma unroll
  for (int dt = 0; dt < 4; ++dt)
#pragma unroll
    for (int a = 0; a < 2; ++a) {
      float xy[2][4];
#pragma unroll
      for (int q2 = 0; q2 < 2; ++q2) {
        const int g = 2 * a + q2;
        const u32x2 z = zv[dt * 4 + g];
        xy[q2][0] = o[dt][4 * g] * inv * bf_lo(z[0]); xy[q2][1] = o[dt][4 * g + 1] * inv * bf_hi(z[0]);
        xy[q2][2] = o[dt][4 * g + 2] * inv * bf_lo(z[1]); xy[q2][3] = o[dt][4 * g + 3] * inv * bf_hi(z[1]);
      }
      st8_pair_bf16(p.MIX + (size_t)qrow * 2048 + 1024 + h * 128 + 32 * dt + 16 * a + 8 * hf, xy[0], xy[1]);
    }
}

DI unsigned xcc_id() { return (unsigned)__builtin_amdgcn_s_getreg((3 << 11) | 20) & 7u; }

DI void phase_attn(const Params& p, int l, char* lds) {
  unsigned* qc = p.counters + 32 + l * 8;
  int* ubox = (int*)(lds + UBOX_OFF);
  const int myx = (int)xcc_id();
  int qi = 0;
  for (;;) {
    __syncthreads();
    if (tid() == 0) {
      int u = -1;
      while (qi < 8) {
        const int x = (myx + qi) & 7;
        const unsigned i = atomicAdd(qc + x, 1u);
        if (i < 96u) { u = x * 96 + (int)i; break; }
        ++qi;
      }
      *ubox = u;
    }
    __syncthreads();
    const int u = *ubox;
    if (u < 0) break;
    const int h = u / 96, i = u - h * 96;
    const int t = tid();
    if (i < 11) mla_unit(p, t, l, h, 31 - i, lds);
    else {
      const int k = i - 11, grp = k >> 2, pos = k & 3;
      if (grp < 21 && pos == 3) mla_unit(p, t, l, h, 20 - grp, lds);
      else diff_unit(p, t, l, h, 63 - (grp * 3 + pos), lds);
    }
  }
}

DI void kr_unit(const Params& p, int l, int mr, char* lds) {
  constexpr int RS2 = 528, TILE2 = 64 * RS2, STG2 = 2 * TILE2;
  const int t = tid(), lane = t & 63, w = t >> 6, r = lane & 31, hf = lane >> 5;
  const int m0 = mr * 64;
  const u16* A = p.XB + (size_t)m0 * DM;
  const u16* Bt = p.WinT + ((size_t)l * INWP + 6144) * DM;
  const unsigned goff = (unsigned)(t >> 3) * (unsigned)DM + (unsigned)(t & 7) * 8u;
  char* const wbase = lds + (t >> 3) * RS2 + (t & 7) * 16;
  u32x4 ra[4], rb[4];
  f32x16 acc[2][2];
#pragma unroll
  for (int mt = 0; mt < 2; ++mt)
#pragma unroll
    for (int nt = 0; nt < 2; ++nt)
#pragma unroll
      for (int i = 0; i < 16; ++i) acc[mt][nt][i] = 0.f;
#define KR_LOAD(SS) do { _Pragma("unroll") for (int j = 0; j < 4; ++j) { \
    ra[j] = *(const u32x4*)(A + (SS) * 256 + 64 * j + goff); rb[j] = *(const u32x4*)(Bt + (SS) * 256 + 64 * j + goff); } } while (0)
#define KR_WRITE(STG) do { char* a_ = wbase + (STG) * STG2; _Pragma("unroll") for (int j = 0; j < 4; ++j) { \
    *(u32x4*)(a_ + 128 * j) = ra[j]; *(u32x4*)(a_ + TILE2 + 128 * j) = rb[j]; } } while (0)
  KR_LOAD(0);
  __syncthreads();
  KR_WRITE(0);
  KR_LOAD(1);
  __syncthreads();
  const char* abase = lds + r * RS2 + 64 * w + hf * 16;
  const char* bbase = abase + TILE2;
#pragma nounroll
  for (int s = 0; s < 8; ++s) {
    const int st = (s & 1) * STG2;
    bf16x8 fa[2][2], fb[2][2];
#pragma unroll
    for (int ks = 0; ks < 2; ++ks)
#pragma unroll
      for (int i = 0; i < 2; ++i) {
        fa[ks][i] = *(const bf16x8*)(abase + st + i * 32 * RS2 + ks * 32);
        fb[ks][i] = *(const bf16x8*)(bbase + st + i * 32 * RS2 + ks * 32);
      }
#pragma unroll
    for (int ks = 0; ks < 2; ++ks)
#pragma unroll
      for (int mt = 0; mt < 2; ++mt)
#pragma unroll
        for (int nt = 0; nt < 2; ++nt) acc[mt][nt] = MFMA32(fb[ks][nt], fa[ks][mt], acc[mt][nt]);
    if (s + 1 < 8) KR_WRITE((s + 1) & 1);
    if (s + 2 < 8) KR_LOAD(s + 2);
    __syncthreads();
  }
#undef KR_LOAD
#undef KR_WRITE
  float* red = (float*)lds;
#pragma unroll
  for (int mt = 0; mt < 2; ++mt)
#pragma unroll
    for (int nt = 0; nt < 2; ++nt)
#pragma unroll
      for (int i = 0; i < 16; ++i) red[(w * 64 + mt * 32 + nt * 16 + i) * 64 + lane] = acc[mt][nt][i];
  __syncthreads();
  {
    const int mt = w >> 2, ig = w & 3;
    const int m = m0 + mt * 32 + r, j = 8 * ig + 4 * hf;
    float x1[4], x2[4];
#pragma unroll
    for (int e = 0; e < 4; ++e) {
      float a1 = 0.f, a2 = 0.f;
#pragma unroll
      for (int ww = 0; ww < 8; ++ww) {
        a1 += red[(ww * 64 + mt * 32 + 4 * ig + e) * 64 + lane];
        a2 += red[(ww * 64 + mt * 32 + 16 + 4 * ig + e) * 64 + lane];
      }
      x1[e] = a1; x2[e] = a2;
    }
    const f32x4* ps = (const f32x4*)(p.XSS + (size_t)m * 32);
    float sacc = 0.f;
#pragma unroll
    for (int i = 0; i < 8; ++i) { const f32x4 v = ps[i]; sacc += (v[0] + v[1]) + (v[2] + v[3]); }
    const float sc = rsqrtf(sacc * (1.0f / DM) + EPS);
    const f32x4 cs = *(const f32x4*)(p.RCOS + (size_t)m * 32 + j);
    const f32x4 sn = *(const f32x4*)(p.RSIN + (size_t)m * 32 + j);
    float o1[4], o2[4];
#pragma unroll
    for (int e = 0; e < 4; ++e) {
      const float y1 = x1[e] * sc, y2 = x2[e] * sc;
      o1[e] = y1 * cs[e] - y2 * sn[e];
      o2[e] = y2 * cs[e] + y1 * sn[e];
    }
#pragma unroll
    for (int rep = 0; rep < 8; ++rep) {
      u16* d = p.KB + (size_t)m * 1536 + 128 + rep * 192 + j;
      st4_bf16(d, o1[0], o1[1], o1[2], o1[3]);
      st4_bf16(d + 32, o2[0], o2[1], o2[2], o2[3]);
    }
  }
}

DI void phase_lat(const Params& p, int l, char* lds) {
  unsigned* ctr = p.counters + 4 + l;
  int* ubox = (int*)(lds + UBOX_OFF);
  for (;;) {
    __syncthreads();
    if (tid() == 0) *ubox = (int)atomicAdd(ctr, 1u);
    __syncthreads();
    const int u = *ubox;
    if (u >= 128 + 448) break;
    if (u < 128) kr_unit(p, l, u, lds); else lat_tile(p, l, u - 128, lds);
  }
}

DI void wt_tile(const float* __restrict__ W, int K, int N, int k0, int n0, const float* __restrict__ g, u16* __restrict__ dst, int nd0, char* lds) {
  float* tile = (float*)lds;
  const int t = tid();
  __syncthreads();
#pragma unroll
  for (int pi = 0; pi < 2; ++pi) {
    const int kk = (t >> 4) + 32 * pi, c4 = (t & 15) * 4;
    f32x4 v = *(const f32x4*)(W + (size_t)(k0 + kk) * N + n0 + c4);
    const float gg = g ? g[k0 + kk] : 1.0f;
    tile[kk * 65 + c4] = v[0] * gg; tile[kk * 65 + c4 + 1] = v[1] * gg; tile[kk * 65 + c4 + 2] = v[2] * gg; tile[kk * 65 + c4 + 3] = v[3] * gg;
  }
  __syncthreads();
  const int n = t >> 3, kc = (t & 7) * 8;
  u32x4 o0;
#pragma unroll
  for (int e = 0; e < 4; ++e) o0[e] = pk_bf16(tile[(kc + 2 * e) * 65 + n], tile[(kc + 2 * e + 1) * 65 + n]);
  u16* d = dst + (size_t)(nd0 + n) * K + k0 + kc;
  *(u32x4*)d = o0;
}

DI void sincos_d(float ang, float& c, float& s) {
  const double x = (double)ang;
  const double n = rint(x * 0.6366197723675814);
  const double rr = (x - n * 1.5707963267948966) - n * 6.123233995736766e-17;
  const int q = ((int)n) & 3;
  const double r2 = rr * rr;
  const double sn = rr * (1.0 + r2 * (-1.0 / 6 + r2 * (1.0 / 120 + r2 * (-1.0 / 5040 + r2 * (1.0 / 362880 + r2 * (-1.0 / 39916800 + r2 * (1.0 / 6227020800.0)))))));
  const double cs = 1.0 + r2 * (-0.5 + r2 * (1.0 / 24 + r2 * (-1.0 / 720 + r2 * (1.0 / 40320 + r2 * (-1.0 / 3628800 + r2 * (1.0 / 479001600.0 + r2 * (-1.0 / 87178291200.0)))))));
  double cc, ssn;
  if (q == 0) { cc = cs; ssn = sn; } else if (q == 1) { cc = -sn; ssn = cs; } else if (q == 2) { cc = -cs; ssn = -sn; } else { cc = sn; ssn = -cs; }
  c = (float)cc; s = (float)ssn;
}

DI void phase0(const Params& p, char* lds) {
  const int t = tid();
  constexpr int NJ0 = 4 * 32 * 97, NJ1 = 4 * 8 * 24, NJ2 = 4 * 8 * 32, NJ3 = 4 * 32 * 32;
  for (int T = blockIdx.x; T < NJ0 + NJ1 + NJ2 + NJ3; T += gridDim.x) {
    if (T < NJ0) {
      const int l = T / (32 * 97), rem = T - l * (32 * 97), kb = rem / 97, nb = rem - kb * 97;
      const int n0 = nb * 64;
      const int nd0 = n0 < 5120 ? n0 : (n0 == 5120 ? 6144 : n0 - 64);
      wt_tile(p.w_in + (size_t)l * DM * INW, DM, INW, kb * 64, n0, p.norm_g + l * DM, p.WinT + (size_t)l * INWP * DM, nd0, lds);
    } else if (T < NJ0 + NJ1) {
      const int T1 = T - NJ0, l = T1 / (8 * 24), rem = T1 - l * (8 * 24), kb = rem / 24, nb = rem - kb * 24;
      wt_tile(p.w_uq + (size_t)l * 512 * 1536, 512, 1536, kb * 64, nb * 64, p.qnorm_g + l * 512, p.WuqT + (size_t)l * 1536 * 512, nb * 64, lds);
    } else if (T < NJ0 + NJ1 + NJ2) {
      const int T1 = T - NJ0 - NJ1, l = T1 / (8 * 32), rem = T1 - l * (8 * 32), kb = rem / 32, nb = rem - kb * 32;
      const int hh = nb >> 2, wi = nb & 3;
      const int nd = (wi < 2) ? (hh * 128 + wi * 64) : (1024 + hh * 128 + (wi - 2) * 64);
      wt_tile(p.w_ukv + (size_t)l * 512 * 2048, 512, 2048, kb * 64, nb * 64, p.kvnorm_g + l * 512, p.WukvT + (size_t)l * 2048 * 512, nd, lds);
    } else {
      const int T1 = T - NJ0 - NJ1 - NJ2, l = T1 / (32 * 32), rem = T1 - l * (32 * 32), kb = rem / 32, nb = rem - kb * 32;
      wt_tile(p.w_out + (size_t)l * 2048 * 2048, 2048, 2048, kb * 64, nb * 64, nullptr, p.WoutT + (size_t)l * 2048 * 2048, nb * 64, lds);
    }
  }
  const int gtid = blockIdx.x * NTHREADS + t, gsz = gridDim.x * NTHREADS;
  for (int i = gtid; i < 4 * 192 * 256; i += gsz) {
    const int l = i / (192 * 256), rem = i - l * (192 * 256);
    u32x4 z = {0u, 0u, 0u, 0u};
    *(u32x4*)(p.WinT + ((size_t)l * INWP + INW) * DM + (size_t)rem * 8) = z;
  }
  for (int i = gtid; i < S * DM / 8; i += gsz) {
    const f32x4 a = *(const f32x4*)(p.x + (size_t)i * 8), b = *(const f32x4*)(p.x + (size_t)i * 8 + 4);
    u32x4 o = {pk_bf16(a[0], a[1]), pk_bf16(a[2], a[3]), pk_bf16(b[0], b[1]), pk_bf16(b[2], b[3])};
    *(u32x4*)(p.XB + (size_t)i * 8) = o;
    float q = (a[0] * a[0] + a[1] * a[1]) + (a[2] * a[2] + a[3] * a[3]) + (b[0] * b[0] + b[1] * b[1]) + (b[2] * b[2] + b[3] * b[3]);
    q += __shfl_xor(q, 1); q += __shfl_xor(q, 2); q += __shfl_xor(q, 4);
    if ((i & 7) == 0) p.XSS[i >> 3] = q;
  }
  for (int i = gtid; i < S * 32; i += gsz) {
    const int pos = i >> 5, j = i & 31;
    const float pw = (float)exp((double)((float)(2 * j) / 64.0f) * 9.210340371976184);
    const float inv = 1.0f / pw;
    const float ang = (float)pos * inv;
    float c, s; sincos_d(ang, c, s);
    p.RCOS[i] = c; p.RSIN[i] = s;
  }
  for (int i = gtid; i < 8 * 132; i += gsz) {
    const int h = i / 132, d = i - h * 132;
    const int n = d > 128 ? 128 : d;
    int bucket;
    if (n < 16) bucket = n;
    else {
      const float nf = (float)n;
      int lg = 16 + (int)(logf(nf / 16.0f) / 2.0794415416798357f * 16.0f);
      bucket = lg > 31 ? 31 : lg;
    }
    p.BLUT[i] = p.bias_tab[bucket * 8 + h] * LOG2E;
  }
  if (gtid < 4) {
    const float* lp = p.diff_lambda + gtid * 256;
    float s1 = 0.f, s2 = 0.f;
    for (int e = 0; e < 64; ++e) { s1 += lp[e] * lp[64 + e]; s2 += lp[128 + e] * lp[192 + e]; }
    p.LAM[gtid] = expf(s1) - expf(s2) + lambda_init(gtid);
    p.LAM[4 + gtid] = 1.0f - lambda_init(gtid);
  }
}

DI void phase_final(const Params& p) {
  const int t = tid(), lane = t & 63, w = t >> 6;
  for (int row = blockIdx.x * 8 + w; row < S; row += gridDim.x * 8) {
    const float* xr = p.X + (size_t)row * DM;
    f32x4 v[8];
    float ss = 0.f;
#pragma unroll
    for (int i = 0; i < 8; ++i) { v[i] = *(const f32x4*)(xr + i * 256 + lane * 4); ss += v[i][0] * v[i][0] + v[i][1] * v[i][1] + v[i][2] * v[i][2] + v[i][3] * v[i][3]; }
#pragma unroll
    for (int o = 1; o < 64; o <<= 1) ss += __shfl_xor(ss, o);
    const float rs = rsqrtf(ss * (1.0f / DM) + EPS);
#pragma unroll
    for (int i = 0; i < 8; ++i) {
      const f32x4 g = *(const f32x4*)(p.final_g + i * 256 + lane * 4);
      f32x4 o = {v[i][0] * rs * g[0], v[i][1] * rs * g[1], v[i][2] * rs * g[2], v[i][3] * rs * g[3]};
      *(f32x4*)(p.out + (size_t)row * DM + i * 256 + lane * 4) = o;
    }
  }
}

DI void run_phase(const Params& p, int ph, char* lds) {
#ifndef PHMASK
#define PHMASK 63
#endif
  if (ph == 0) { if (PHMASK & 1) phase0(p, lds); return; }
  if (ph == 17) { if (PHMASK & 2) phase_final(p); return; }
  const int l = (ph - 1) >> 2, sub = (ph - 1) & 3;
  if (sub == 0 && (PHMASK & 4)) {
    for (int T = blockIdx.x; T < 32 * 24; T += gridDim.x) inproj_tile(p, l, T & 31, T >> 5, lds);
  } else if (sub == 1 && (PHMASK & 8)) {
    phase_lat(p, l, lds);
  } else if (sub == 2 && (PHMASK & 16)) {
    phase_attn(p, l, lds);
  } else if (sub == 3 && (PHMASK & 32)) {
    for (int T = blockIdx.x; T < 32 * 8; T += gridDim.x) out_tile(p, l, T & 31, T >> 5, lds);
  }
}

#if ONE_LAUNCH
DI void grid_bar(unsigned* cw, unsigned xcc, unsigned nx, unsigned nxp, unsigned gen) {
  __syncthreads();
  if (tid() == 0) {
    const unsigned old = __hip_atomic_fetch_add(cw + 256 + 16 * xcc, 1u, __ATOMIC_RELAXED, __HIP_MEMORY_SCOPE_AGENT);
    if (old + 1u == nx * gen) {
      __builtin_amdgcn_fence(__ATOMIC_RELEASE, "agent");
      asm volatile("s_waitcnt vmcnt(0)" ::: "memory");
      __hip_atomic_fetch_add(cw + 512, 1u, __ATOMIC_RELAXED, __HIP_MEMORY_SCOPE_AGENT);
    }
    while (__hip_atomic_load(cw + 512, __ATOMIC_RELAXED, __HIP_MEMORY_SCOPE_AGENT) < nxp * gen) __builtin_amdgcn_s_sleep(4);
    __builtin_amdgcn_fence(__ATOMIC_ACQUIRE, "agent");
    asm volatile("s_waitcnt vmcnt(0)" ::: "memory");
  }
  __syncthreads();
}
__global__ void __launch_bounds__(NTHREADS, 2) fwd_kernel(Params p) {
  __shared__ __attribute__((aligned(16))) char lds[LDS_BYTES];
  cg::grid_group grid = cg::this_grid();
  unsigned* cw = p.counters;
  const unsigned xcc = xcc_id();
  if (tid() == 0) __hip_atomic_fetch_add(cw + 64 + 16 * xcc, 1u, __ATOMIC_RELAXED, __HIP_MEMORY_SCOPE_AGENT);
  phase0(p, lds);
  grid.sync();
  unsigned nx = 0, nxp = 0;
#pragma unroll
  for (int j = 0; j < 8; ++j) {
    const unsigned c = (unsigned)__builtin_amdgcn_readfirstlane((int)__hip_atomic_load(cw + 64 + 16 * j, __ATOMIC_RELAXED, __HIP_MEMORY_SCOPE_AGENT));
    nxp += (c != 0u) ? 1u : 0u;
    if ((unsigned)j == xcc) nx = c;
  }
  nx = (unsigned)__builtin_amdgcn_readfirstlane((int)nx);
  nxp = (unsigned)__builtin_amdgcn_readfirstlane((int)nxp);
  unsigned gen = 0;
#pragma nounroll
  for (int l = 0; l < DEPTH; ++l) {
    for (int T = blockIdx.x; T < 32 * 24; T += gridDim.x) inproj_tile(p, l, T & 31, T >> 5, lds);
    grid_bar(cw, xcc, nx, nxp, ++gen);
    phase_lat(p, l, lds);
    grid_bar(cw, xcc, nx, nxp, ++gen);
    phase_attn(p, l, lds);
    grid_bar(cw, xcc, nx, nxp, ++gen);
    for (int T = blockIdx.x; T < 32 * 8; T += gridDim.x) out_tile(p, l, T & 31, T >> 5, lds);
    grid_bar(cw, xcc, nx, nxp, ++gen);
  }
  phase_final(p);
}
#else
__global__ void __launch_bounds__(NTHREADS, 2) fwd_kernel(Params p, int ph) {
  __shared__ __attribute__((aligned(16))) char lds[LDS_BYTES];
  run_phase(p, ph, lds);
}
#endif

extern "C" void kernel_launch(void* const* d_in, const int* in_sizes, int n_in, void* d_out, int out_size, void* d_ws, size_t ws_size,
                              hipStream_t stream) {
  Params p{};
  p.x = (const float*)d_in[0]; p.norm_g = (const float*)d_in[1]; p.w_in = (const float*)d_in[2]; p.diff_lambda = (const float*)d_in[3];
  p.subln_g = (const float*)d_in[4]; p.bias_tab = (const float*)d_in[5]; p.qnorm_g = (const float*)d_in[6]; p.w_uq = (const float*)d_in[7];
  p.kvnorm_g = (const float*)d_in[8]; p.w_ukv = (const float*)d_in[9]; p.w_out = (const float*)d_in[10]; p.final_g = (const float*)d_in[11];
  p.out = (float*)d_out;
  char* ws = (char*)d_ws;
  size_t off = 0;
  auto take = [&](size_t bytes) { char* r = ws + off; off += (bytes + 255) & ~(size_t)255; return r; };
  p.counters = (unsigned*)take(4096);
  p.LAM = (float*)take(256);
  p.BLUT = (float*)take(8 * 132 * 4);
  p.RCOS = (float*)take((size_t)S * 32 * 4);
  p.RSIN = (float*)take((size_t)S * 32 * 4);
  p.WinT = (u16*)take((size_t)DEPTH * INWP * DM * 2);
  p.WuqT = (u16*)take((size_t)DEPTH * 1536 * 512 * 2);
  p.WukvT = (u16*)take((size_t)DEPTH * 2048 * 512 * 2);
  p.WoutT = (u16*)take((size_t)DEPTH * 2048 * 2048 * 2);
  p.X = (float*)take((size_t)S * DM * 4);
  p.XB = (u16*)take((size_t)S * DM * 2);
  p.QA = (u16*)take((size_t)S * 1024 * 2);
  p.KA = (u16*)take((size_t)S * 1024 * 2);
  p.VAT = (u16*)take((size_t)S * 1024 * 2);
  p.ZG = (u16*)take((size_t)S * 2048 * 2);
  p.CQ = (u16*)take((size_t)S * 512 * 2);
  p.CKV = (u16*)take((size_t)S * 512 * 2);
  p.KB = (u16*)take((size_t)S * 1536 * 2);
  p.QB = (u16*)take((size_t)S * 1536 * 2);
  p.VBT = (u16*)take((size_t)S * 1024 * 2);
  p.MIX = (u16*)take((size_t)S * 2048 * 2);
  p.STASH = (float*)take((size_t)512 * 64 * NTHREADS * 4);
  p.XSS = (float*)take((size_t)S * 32 * 4);

  static int grid_blocks = 0;
  if (!grid_blocks) {
    int dev = 0, cus = 0, per_cu = 0;
    hipGetDevice(&dev);
    hipDeviceGetAttribute(&cus, hipDeviceAttributeMultiprocessorCount, dev);
    hipOccupancyMaxActiveBlocksPerMultiprocessor(&per_cu, fwd_kernel, NTHREADS, 0);
    if (per_cu > 1) per_cu = 1;
    if (per_cu < 1) per_cu = 1;
    grid_blocks = cus * per_cu;
  }
  hipMemsetAsync(p.counters, 0, 4096, stream);
#if ONE_LAUNCH
  void* args[] = {&p};
  hipError_t e = hipLaunchCooperativeKernel((void*)fwd_kernel, dim3(grid_blocks), dim3(NTHREADS), args, 0, stream);
  if (e != hipSuccess) fprintf(stderr, "cooperative launch failed: %s (grid %d)\n", hipGetErrorString(e), grid_blocks);
#else
  for (int ph = 0; ph < 18; ++ph) fwd_kernel<<<grid_blocks, NTHREADS, 0, stream>>>(p, ph);
#endif
}
```
